# Optimizing an MI355X kernel written in HIP

```python
import jax, jax.numpy as jnp
from jax import lax
import numpy as np

D_MODEL = 1024
BATCH = 32
SEQ = 2048
DEPTH = 2

HEAD_DIM = 64
Q_BLOCK = 128
EPS = 1e-6
A_HEADS = 8
A_W = A_HEADS * HEAD_DIM
B_HEADS = 8
B_W = B_HEADS * HEAD_DIM
B_Q_RANK = 256
B_KV_RANK = 128
IDX_HEADS = 8
IDX_DIM = 32
IDX_TOPK_MAX = 256
C_GROUPS = ((128, 1), (512, 4), (2048, 16))
C_HEADS_PER_GROUP = 4
C_HEADS = C_HEADS_PER_GROUP * len(C_GROUPS)
C_W = C_HEADS * HEAD_DIM
IN_WIDTHS = (A_W, A_W, A_W, A_HEADS, A_W,
             B_Q_RANK, B_KV_RANK, IDX_DIM, IDX_HEADS, B_W,
             C_W, C_W, C_W, C_W,
             D_MODEL, D_MODEL, D_MODEL)
D_IN = sum(IN_WIDTHS)

kernel_name = "hybrid_fox_dsa_dilated_gated"

F32 = jnp.float32


def rmsnorm(x, g):
    xf = x.astype(F32)
    y = xf * lax.rsqrt(jnp.mean(xf * xf, axis=-1, keepdims=True) + EPS)
    return (y * g.astype(F32)).astype(x.dtype)


def alibi_slopes(n):
    return jnp.exp2(-8.0 * (jnp.arange(n, dtype=F32) + 1.0) / n)


def _unblock(y, batch, seq):
    return jnp.swapaxes(y, 0, 1).reshape((batch, seq) + y.shape[3:])


def forgetting_attention(q, k, v, log_f):
    B, S, H, Dh = q.shape
    scale = Dh ** -0.5
    c = jnp.cumsum(log_f, axis=1).transpose(0, 2, 1)
    kpos = jnp.arange(S)

    def block(i):
        t0 = i * Q_BLOCK
        qb = lax.dynamic_slice_in_dim(q, t0, Q_BLOCK, 1)
        cb = lax.dynamic_slice_in_dim(c, t0, Q_BLOCK, 2)
        qpos = t0 + jnp.arange(Q_BLOCK)
        logits = jnp.einsum('bqhd,bkhd->bhqk', qb, k, preferred_element_type=F32) * scale
        logits = logits + (cb[..., :, None] - c[..., None, :])
        logits = jnp.where(kpos[None, :] <= qpos[:, None], logits, -jnp.inf)
        p = jax.nn.softmax(logits, axis=-1)
        return jnp.einsum('bhqk,bkhd->bqhd', p.astype(v.dtype), v)

    out = lax.map(block, jnp.arange(S // Q_BLOCK))
    return _unblock(out, B, S)


def dsa_attention(q, k, v, q_idx, k_idx, w_idx, slopes):
    B, S, H, Dh = q.shape
    top_k = min(IDX_TOPK_MAX, S // 4)
    scale = Dh ** -0.5
    kpos = jnp.arange(S)
    bidx = jnp.arange(B)[:, None, None]

    def block(i):
        t0 = i * Q_BLOCK
        qpos = t0 + jnp.arange(Q_BLOCK)
        qib = lax.dynamic_slice_in_dim(q_idx, t0, Q_BLOCK, 1)
        wb = lax.dynamic_slice_in_dim(w_idx, t0, Q_BLOCK, 1)
        dots = jnp.einsum('bqhd,bkd->bqhk', qib, k_idx, preferred_element_type=F32)
        score = jnp.einsum('bqh,bqhk->bqk', wb.astype(F32), jax.nn.relu(dots))
        score = jnp.where(kpos[None, :] <= qpos[:, None], score, -jnp.inf)
        _, sel = lax.top_k(score, top_k)
        ks = k[bidx, sel]
        vs = v[bidx, sel]
        qb = lax.dynamic_slice_in_dim(q, t0, Q_BLOCK, 1)
        logits = jnp.einsum('bqhd,bqkd->bhqk', qb, ks, preferred_element_type=F32) * scale
        dist = (qpos[None, :, None] - sel).astype(F32)
        logits = logits - slopes[None, :, None, None] * dist[:, None]
        valid = sel <= qpos[None, :, None]
        logits = jnp.where(valid[:, None], logits, -jnp.inf)
        p = jax.nn.softmax(logits, axis=-1)
        return jnp.einsum('bhqk,bqkd->bqhd', p.astype(vs.dtype), vs)

    out = lax.map(block, jnp.arange(S // Q_BLOCK))
    return _unblock(out, B, S)


def _dilated_group(q, k, v, slopes, window, dilation):
    B, S, H, Dh = q.shape
    scale = Dh ** -0.5
    n_keys = window // dilation + 1
    kp = jnp.pad(k, ((0, 0), (window, 0), (0, 0), (0, 0)))
    vp = jnp.pad(v, ((0, 0), (window, 0), (0, 0), (0, 0)))
    j = jnp.arange(n_keys)
    rel = jnp.arange(Q_BLOCK)[:, None] + window - j[None, :] * dilation
    dist = (j * dilation).astype(F32)

    def block(i):
        t0 = i * Q_BLOCK
        qpos = t0 + jnp.arange(Q_BLOCK)
        qb = lax.dynamic_slice_in_dim(q, t0, Q_BLOCK, 1)
        kband = lax.dynamic_slice_in_dim(kp, t0, Q_BLOCK + window, 1)
        vband = lax.dynamic_slice_in_dim(vp, t0, Q_BLOCK + window, 1)
        ks = kband[:, rel]
        vs = vband[:, rel]
        logits = jnp.einsum('bqhd,bqjhd->bhqj', qb, ks, preferred_element_type=F32) * scale
        logits = logits - slopes[None, :, None, None] * dist[None, None, None, :]
        valid = (qpos[:, None] - j[None, :] * dilation) >= 0
        logits = jnp.where(valid, logits, -jnp.inf)
        lse = jax.nn.logsumexp(logits, axis=-1)
        p = jnp.exp(logits - lse[..., None])
        o = jnp.einsum('bhqj,bqjhd->bqhd', p.astype(vs.dtype), vs)
        return o, lse.transpose(0, 2, 1)

    o, lse = lax.map(block, jnp.arange(S // Q_BLOCK))
    return _unblock(o, B, S), _unblock(lse, B, S)


def dilated_attention(q, k, v, slopes):
    hg = C_HEADS_PER_GROUP
    outs, lses = [], []
    for g, (window, dilation) in enumerate(C_GROUPS):
        hs = slice(g * hg, (g + 1) * hg)
        o, lse = _dilated_group(q[:, :, hs], k[:, :, hs], v[:, :, hs], slopes[hs], window, dilation)
        outs.append(o)
        lses.append(lse)
    alpha = jax.nn.softmax(jnp.stack(lses, axis=0), axis=0)
    return jnp.concatenate([(alpha[g][..., None] * outs[g]).astype(q.dtype) for g in range(len(C_GROUPS))], axis=2)


def hybrid_layer(x, norm_g, w_in, b_forget, g_cq, w_uq, w_uq_idx, g_ckv, w_ukv, w_a, w_b, w_c, w_o):
    B, S, _ = x.shape
    hd = HEAD_DIM
    h = rmsnorm(x, norm_g)
    proj = h @ w_in
    points = np.cumsum(IN_WIDTHS)[:-1].tolist()
    (qa, ka, va, fa, za, cq, ckv, kidx, widx, zb, qc, kc, vc, zc, ga, gb, gc) = jnp.split(proj, points, axis=-1)

    log_f = jax.nn.log_sigmoid((fa + b_forget).astype(F32))
    ya = forgetting_attention(qa.reshape(B, S, A_HEADS, hd), ka.reshape(B, S, A_HEADS, hd),
                              va.reshape(B, S, A_HEADS, hd), log_f)
    ya = ya.reshape(B, S, A_W) * jax.nn.silu(za)

    cq = rmsnorm(cq, g_cq)
    qb = (cq @ w_uq).reshape(B, S, B_HEADS, hd)
    q_idx = (cq @ w_uq_idx).reshape(B, S, IDX_HEADS, IDX_DIM)
    kv = rmsnorm(ckv, g_ckv) @ w_ukv
    yb = dsa_attention(qb, kv[..., :hd], kv[..., hd:], q_idx, kidx, widx, alibi_slopes(B_HEADS))
    yb = yb.reshape(B, S, B_W) * jax.nn.silu(zb)

    yc = dilated_attention(qc.reshape(B, S, C_HEADS, hd), kc.reshape(B, S, C_HEADS, hd),
                           vc.reshape(B, S, C_HEADS, hd), alibi_slopes(C_HEADS))
    yc = yc.reshape(B, S, C_W) * jax.nn.silu(zc)

    merged = (jax.nn.sigmoid(ga) * (ya @ w_a) + jax.nn.sigmoid(gb) * (yb @ w_b)
              + jax.nn.sigmoid(gc) * (yc @ w_c))
    return (x + merged @ w_o).astype(x.dtype)


def setup_inputs(seed: int = 0) -> dict:
    key = jax.random.key(seed)
    ks = jax.random.split(key, 16)
    nrm = lambda k, shape, fan_in: jax.random.normal(k, shape, F32) * (fan_in ** -0.5)
    return {
        "x": jax.random.normal(ks[0], (BATCH, SEQ, D_MODEL), F32),
        "norm_g": 1.0 + 0.05 * jax.random.normal(ks[1], (DEPTH, D_MODEL), F32),
        "w_in": nrm(ks[2], (DEPTH, D_MODEL, D_IN), D_MODEL),
        "b_forget": 1.0 + 0.5 * jax.random.normal(ks[3], (DEPTH, A_HEADS), F32),
        "g_cq": 1.0 + 0.05 * jax.random.normal(ks[4], (DEPTH, B_Q_RANK), F32),
        "w_uq": nrm(ks[5], (DEPTH, B_Q_RANK, B_W), B_Q_RANK),
        "w_uq_idx": nrm(ks[6], (DEPTH, B_Q_RANK, IDX_HEADS * IDX_DIM), B_Q_RANK),
        "g_ckv": 1.0 + 0.05 * jax.random.normal(ks[7], (DEPTH, B_KV_RANK), F32),
        "w_ukv": nrm(ks[8], (DEPTH, B_KV_RANK, 2 * HEAD_DIM), B_KV_RANK),
        "w_a": nrm(ks[9], (DEPTH, A_W, D_MODEL), A_W),
        "w_b": nrm(ks[10], (DEPTH, B_W, D_MODEL), B_W),
        "w_c": nrm(ks[11], (DEPTH, C_W, D_MODEL), C_W),
        "w_o": nrm(ks[12], (DEPTH, D_MODEL, D_MODEL), D_MODEL),
        "final_g": 1.0 + 0.05 * jax.random.normal(ks[13], (D_MODEL,), F32),
    }


def reference(x, norm_g, w_in, b_forget, g_cq, w_uq, w_uq_idx, g_ckv, w_ukv, w_a, w_b, w_c, w_o, final_g):
    for l in range(DEPTH):
        x = hybrid_layer(x, norm_g[l], w_in[l], b_forget[l], g_cq[l], w_uq[l], w_uq_idx[l],
                         g_ckv[l], w_ukv[l], w_a[l], w_b[l], w_c[l], w_o[l])
    return rmsnorm(x, final_g)
```

```cpp
#include <hip/hip_runtime.h>
#include <cstdio>
#include <cstdint>

#define GAS __attribute__((address_space(1)))
#define LAS __attribute__((address_space(3)))
typedef unsigned short bf16;
typedef short bf16x8 __attribute__((ext_vector_type(8)));
typedef float f32x4 __attribute__((ext_vector_type(4)));
typedef float f32x16 __attribute__((ext_vector_type(16)));
typedef unsigned u32x4 __attribute__((ext_vector_type(4)));
typedef unsigned u32x2 __attribute__((ext_vector_type(2)));
typedef int i32x4 __attribute__((ext_vector_type(4)));

constexpr int S = 2048, NBATCH = 32, D = 1024, MALL = NBATCH * S, DIN = 9136;
constexpr int CB = 16, NCH = NBATCH / CB, TC = CB * S;
constexpr int N1 = 9984;
constexpr float EPS = 1e-6f, LOG2E = 1.4426950408889634f, LN2 = 0.6931471805599453f;
constexpr float XCLIP = 5.0f, XQ_SCALE = 127.0f / XCLIP;
constexpr float SSQ_SCALE = 1048576.0f;
constexpr float QS = 0.125f * LOG2E;
constexpr int C_QA = 0, C_KA = 512, C_VA = 1024, C_QC = 1536, C_KC = 2304, C_VC = 3072, C_CQ = 3840, C_QB = 4096, C_QI = 4608,
              C_CKV = 4864, C_KI = 4992, C_WI = 5024, C_FA = 5032, C_PAD = 5040, C_Z = 5120, C_G = 6912;
constexpr int S_QA = 0, S_KA = 512, S_VA = 1024, S_FA = 1536, S_ZA = 1544, S_CQ = 2056, S_CKV = 2312, S_KI = 2440, S_WI = 2472, S_ZB = 2480,
              S_QC = 2992, S_KC = 3760, S_VC = 4528, S_ZC = 5296, S_GA = 6064, S_GB = 7088, S_GC = 8112;

__host__ __device__ constexpr int src_col(int n) {
    return n < 1536 ? n
         : n < C_KC ? S_QC + (n - C_QC) : n < C_VC ? S_KC + (n - C_KC) : n < C_CQ ? S_VC + (n - C_VC)
         : n < C_QB ? S_CQ + (n - C_CQ) : n < C_CKV ? -2
         : n < C_KI ? S_CKV + (n - C_CKV) : n < C_WI ? S_KI + (n - C_KI) : n < C_FA ? S_WI + (n - C_WI) : n < C_PAD ? S_FA + (n - C_FA)
         : n < C_Z ? -1
         : n < C_Z + 512 ? S_ZA + (n - C_Z) : n < C_Z + 1024 ? S_ZB + (n - C_Z - 512) : n < C_G ? S_ZC + (n - C_Z - 1024)
         : n < C_G + 1024 ? S_GA + (n - C_G) : n < C_G + 2048 ? S_GB + (n - C_G - 1024) : S_GC + (n - C_G - 2048);
}

constexpr size_t MiB = 1u << 20;
constexpr size_t WS_CTL = 0, CTL_ZERO_BYTES = 1 * MiB;
constexpr size_t WS_W1T = 1 * MiB;
constexpr size_t WS_WAT = 40 * MiB, WS_WBT = 42 * MiB, WS_WCT = 44 * MiB, WS_WOT = 47 * MiB, WS_WKVT = 51 * MiB;
constexpr size_t WS_SSQ = 52 * MiB;
constexpr size_t WS_PAD16 = 54 * MiB;
constexpr size_t WS_XB = 56 * MiB;
constexpr size_t WS_CH = 184 * MiB;
constexpr size_t O_QKVA = 0, O_QKVC = O_QKVA + (size_t)TC * 3072, O_QB = O_QKVC + (size_t)TC * 4608, O_QI = O_QB + (size_t)TC * 1024,
                 O_CKV = O_QI + (size_t)TC * 512, O_KI = O_CKV + (size_t)TC * 256, O_WF = O_KI + (size_t)TC * 64, O_SSQC = O_WF + (size_t)TC * 64,
                 O_KVB = O_SSQC + (size_t)TC * 32, O_CUM = O_KVB + (size_t)TC * 256, O_ZY = O_CUM + (size_t)TC * 32, O_G = O_ZY + (size_t)TC * 3584,
                 O_MASK = O_G + (size_t)TC * 3072, O_LSE = O_MASK + (size_t)TC * 256, O_MRG = O_LSE + (size_t)TC * 64, O_CQT = O_MRG + (size_t)TC * 2048,
                 O_END = O_CQT;
constexpr size_t WS_XQ = ((WS_CH + O_END + MiB - 1) / MiB) * MiB;
constexpr size_t WS_W1Q = WS_XQ + (size_t)MALL * 1024;
constexpr size_t WS_END = WS_W1Q + (size_t)2 * N1 * 1024;
static_assert(WS_W1T + (size_t)2 * N1 * 1024 * 2 <= WS_WAT, "w1t");

constexpr int CW_TMO = 0, CW_BAR = 4096, CW_Q = 8192, CW_CMAX = 16384, CW_CS16 = 65536;
constexpr int L_CS16 = 131072;
constexpr int LDS_BYTES = 163840, MISC_OFF = 163840 - 256;
constexpr int NWAVES = 8, NT = 512;


__device__ __forceinline__ unsigned f2bf(float f) { unsigned u = __builtin_bit_cast(unsigned, f); return (u + 0x7fffu + ((u >> 16) & 1u)) >> 16; }
__device__ __forceinline__ unsigned pk2(float lo, float hi) { return f2bf(lo) | (f2bf(hi) << 16); }
__device__ __forceinline__ float bf2f(unsigned short b) { return __builtin_bit_cast(float, (unsigned)b << 16); }
__device__ __forceinline__ float bflo(unsigned w) { return __builtin_bit_cast(float, w << 16); }
__device__ __forceinline__ float bfhi(unsigned w) { return __builtin_bit_cast(float, w & 0xffff0000u); }
__device__ __forceinline__ float fexp2(float x) { return __builtin_amdgcn_exp2f(x); }
__device__ __forceinline__ float sigmoidf_(float x) { return __builtin_amdgcn_rcpf(1.f + __builtin_amdgcn_exp2f(-LOG2E * x)); }
__device__ __forceinline__ float siluf_(float x) { return x * __builtin_amdgcn_rcpf(1.f + __builtin_amdgcn_exp2f(-LOG2E * x)); }
__device__ __forceinline__ float logsigmoidf_(float x) { return fminf(x, 0.f) - log1pf(__expf(-fabsf(x))); }
__device__ __forceinline__ float shx(float v, int o, int lane) { return __int_as_float(__builtin_amdgcn_ds_bpermute((lane ^ o) << 2, __float_as_int(v))); }
__device__ __forceinline__ float shup(float v, int o, int lane) { return __int_as_float(__builtin_amdgcn_ds_bpermute((lane - o) << 2, __float_as_int(v))); }
__device__ __forceinline__ int shupi(int v, int o, int lane) { return __builtin_amdgcn_ds_bpermute((lane - o) << 2, v); }
__device__ __forceinline__ float wave_sum(float v, int lane) {
#pragma unroll
    for (int o = 1; o < 64; o <<= 1) v += shx(v, o, lane);
    return v;
}

#define XB_TMO      128
#define XB_XCNT(j)  (256  + 64 * (j))
#define XB_XSUB(j)  (1280 + 64 * (j))
#define XB_XGEN(j)  (2304 + 64 * (j))
#define XB_TOP      3328
#define XB_TOPGEN   3392
#define XCD_BAR_WORDS 3456
#define XB_SPIN_CAP (1u << 22)
__device__ __forceinline__ unsigned xb_ld(unsigned* p)              { return __hip_atomic_load(p, __ATOMIC_RELAXED, __HIP_MEMORY_SCOPE_AGENT); }
__device__ __forceinline__ unsigned xb_add(unsigned* p, unsigned v) { return __hip_atomic_fetch_add(p, v, __ATOMIC_RELAXED, __HIP_MEMORY_SCOPE_AGENT); }
__device__ __forceinline__ unsigned xb_xcc_id() { return (unsigned)__builtin_amdgcn_s_getreg((3 << 11) | 20) & 0xFu; }
#define XB_SPIN(cond, bar) do { unsigned _sp = 0; while (cond) { __builtin_amdgcn_s_sleep(1); \
    if ((++_sp & 255u) == 0u) { if (xb_ld(&(bar)[XB_TMO])) break; if (_sp > XB_SPIN_CAP) { atomicAdd(&(bar)[XB_TMO], 1u); break; } } } } while (0)
struct XcdBarrier { unsigned* bar; unsigned x; volatile LAS unsigned* st; };
__device__ __forceinline__ XcdBarrier xcd_barrier_post(unsigned* bar, volatile LAS unsigned* st) {
    XcdBarrier b; b.bar = bar; b.x = xb_xcc_id(); b.st = st;
    if (threadIdx.x == 0) (void)xb_add(&bar[XB_XCNT(b.x)], 1u);
    return b;
}
__device__ __forceinline__ void xcd_barrier_complete(unsigned* bar, unsigned x, unsigned& nloc, unsigned& nx) {
    const unsigned G = gridDim.x * gridDim.y * gridDim.z;
    unsigned sum, cnt, mine, sp = 0u;
    for (;;) {
        sum = 0u; cnt = 0u; mine = 0u;
#pragma unroll 1
        for (unsigned j = 0; j < 16; ++j) { const unsigned c = xb_ld(&bar[XB_XCNT(j)]); sum += c; cnt += (c > 0u) ? 1u : 0u; mine = (j == x) ? c : mine; }
        if (sum == G) break;
        __builtin_amdgcn_s_sleep(1);
        if ((++sp & 255u) == 0u) { if (xb_ld(&bar[XB_TMO])) break; if (sp > XB_SPIN_CAP) { atomicAdd(&bar[XB_TMO], 1u); break; } }
    }
    nloc = mine > 0u ? mine : 1u; nx = cnt > 0u ? cnt : 1u;
}
__device__ __forceinline__ int lane_now() { int l; asm volatile("v_mbcnt_lo_u32_b32 %0, -1, 0\n\tv_mbcnt_hi_u32_b32 %0, -1, %0" : "=v"(l)); return l; }
__device__ __forceinline__ void xcd_barrier(const XcdBarrier& b, int wave) {
    asm volatile("s_waitcnt vmcnt(0)" ::: "memory");
    __syncthreads();
    if (wave == 0 && lane_now() == 0) {
        unsigned* bar = b.bar;
        __builtin_amdgcn_s_waitcnt(0);
        unsigned nloc = b.st[0], nx = b.st[1];
        if (nloc == 0u) { xcd_barrier_complete(bar, b.x, nloc, nx); b.st[0] = nloc; b.st[1] = nx; }
        const unsigned old = xb_add(&bar[XB_XSUB(b.x)], 1u);
        const unsigned gen = old / nloc;
        if (old + 1u == (gen + 1u) * nloc) {
            __builtin_amdgcn_fence(__ATOMIC_RELEASE, "agent");
            asm volatile("s_waitcnt vmcnt(0)" ::: "memory");
            const unsigned og = xb_add(&bar[XB_TOP], 1u);
            const unsigned tg = og / nx;
            if (og + 1u == (tg + 1u) * nx) xb_add(&bar[XB_TOPGEN], 1u);
            else XB_SPIN(xb_ld(&bar[XB_TOPGEN]) == tg, bar);
            xb_add(&bar[XB_XGEN(b.x)], 1u);
            __builtin_amdgcn_fence(__ATOMIC_ACQUIRE, "agent");
            asm volatile("s_waitcnt vmcnt(0)" ::: "memory");
        } else {
            XB_SPIN(xb_ld(&bar[XB_XGEN(b.x)]) == gen, bar);
            __builtin_amdgcn_fence(__ATOMIC_ACQUIRE, "agent");
            asm volatile("s_waitcnt vmcnt(0)" ::: "memory");
        }
    }
    __syncthreads();
}

struct Args { const float* in[14]; float* out; unsigned char* ws; int lo, hi; };
struct Ctx {
    int tid, lane, wave, G, bid, gw, NGW;
    LAS unsigned char* lds;
    unsigned char* ws; float* out;
    const float* const* in;
    int layer, chunk, row0;
    int dry;
};
#define X_IN(c, i) ((c).in[i])
#define P_X(c) X_IN(c, 0)
#define P_NORMG(c) X_IN(c, 1)
#define P_WIN(c) X_IN(c, 2)
#define P_BF(c) X_IN(c, 3)
#define P_GCQ(c) X_IN(c, 4)
#define P_WUQ(c) X_IN(c, 5)
#define P_WUQI(c) X_IN(c, 6)
#define P_GCKV(c) X_IN(c, 7)
#define P_WUKV(c) X_IN(c, 8)
#define P_WA(c) X_IN(c, 9)
#define P_WB(c) X_IN(c, 10)
#define P_WC(c) X_IN(c, 11)
#define P_WO(c) X_IN(c, 12)
#define P_FG(c) X_IN(c, 13)
#define CHP(c, off) ((c).ws + WS_CH + (off))
#define B_QKVA(c) ((bf16*)CHP(c, O_QKVA))
#define B_QKVC(c) ((bf16*)CHP(c, O_QKVC))
#define B_QB(c) ((bf16*)CHP(c, O_QB))
#define B_QI(c) ((bf16*)CHP(c, O_QI))
#define B_CKV(c) ((bf16*)CHP(c, O_CKV))
#define B_KI(c) ((bf16*)CHP(c, O_KI))
#define B_WF(c) ((float*)CHP(c, O_WF))
#define B_SSQC(c) ((float*)CHP(c, O_SSQC))
#define B_KVB(c) ((bf16*)CHP(c, O_KVB))
#define B_CUM(c) ((float*)CHP(c, O_CUM))
#define B_ZY(c) ((bf16*)CHP(c, O_ZY))
#define B_G(c) ((bf16*)CHP(c, O_G))
#define B_MASK(c) ((unsigned*)CHP(c, O_MASK))
#define B_LSE(c) ((float*)CHP(c, O_LSE))
#define B_MRG(c) ((bf16*)CHP(c, O_MRG))
#define B_W1T(c) ((bf16*)((c).ws + WS_W1T) + (size_t)(c).layer * N1 * 1024)
#define B_WAT(c) ((bf16*)((c).ws + WS_WAT) + (size_t)(c).layer * 1024 * 512)
#define B_WBT(c) ((bf16*)((c).ws + WS_WBT) + (size_t)(c).layer * 1024 * 512)
#define B_WCT(c) ((bf16*)((c).ws + WS_WCT) + (size_t)(c).layer * 1024 * 768)
#define B_WOT(c) ((bf16*)((c).ws + WS_WOT) + (size_t)(c).layer * 1024 * 1024)
#define B_WKVT(c) ((bf16*)((c).ws + WS_WKVT) + (size_t)(c).layer * 128 * 128)
#define B_XB(c) ((bf16*)((c).ws + WS_XB))
#define B_SSQ(c) ((unsigned long long*)((c).ws + WS_SSQ) + (size_t)(c).layer * MALL)
__device__ __forceinline__ void ctx_set(Ctx& c, int layer, int chunk) { c.layer = layer; c.chunk = chunk; c.row0 = chunk * TC; }

template <class ColFn>
__device__ __forceinline__ void tr_item(const float* W, int ldw, const float* gain, bf16* WT, int K, int NB32, int item, LAS float* scr, int lane, ColFn colf, unsigned* cmax = nullptr) {
    const int kb = item / NB32, nb = item % NB32, k0 = 64 * kb, n0 = 32 * nb;
    const int c4 = 4 * (lane & 7), sc = colf(n0 + c4);
    f32x4 v[8];
#pragma unroll
    for (int i = 0; i < 8; ++i) { const int kk = 8 * i + (lane >> 3);
        v[i] = sc >= 0 ? *(const f32x4*)(W + (size_t)(k0 + kk) * ldw + sc) : (f32x4){0.f, 0.f, 0.f, 0.f}; }
    float gv[8];
#pragma unroll
    for (int i = 0; i < 8; ++i) gv[i] = gain ? gain[k0 + 8 * i + (lane >> 3)] : 1.0f;
    f32x4 mx = {0.f, 0.f, 0.f, 0.f};
#pragma unroll
    for (int i = 0; i < 8; ++i) { const int kk = 8 * i + (lane >> 3); f32x4 q = v[i]; if (gain) q = q * gv[i];
        mx.x = fmaxf(mx.x, fabsf(q.x)); mx.y = fmaxf(mx.y, fabsf(q.y)); mx.z = fmaxf(mx.z, fabsf(q.z)); mx.w = fmaxf(mx.w, fabsf(q.w));
        scr[kk * 33 + c4] = q.x; scr[kk * 33 + c4 + 1] = q.y; scr[kk * 33 + c4 + 2] = q.z; scr[kk * 33 + c4 + 3] = q.w; }
    if (cmax) {
#pragma unroll
        for (int o = 8; o < 64; o <<= 1) { mx.x = fmaxf(mx.x, shx(mx.x, o, lane)); mx.y = fmaxf(mx.y, shx(mx.y, o, lane)); mx.z = fmaxf(mx.z, shx(mx.z, o, lane)); mx.w = fmaxf(mx.w, shx(mx.w, o, lane)); }
        if (lane < 8) { unsigned* cp = cmax + n0 + c4;
            __hip_atomic_fetch_max(cp, __float_as_uint(mx.x), __ATOMIC_RELAXED, __HIP_MEMORY_SCOPE_AGENT); __hip_atomic_fetch_max(cp + 1, __float_as_uint(mx.y), __ATOMIC_RELAXED, __HIP_MEMORY_SCOPE_AGENT);
            __hip_atomic_fetch_max(cp + 2, __float_as_uint(mx.z), __ATOMIC_RELAXED, __HIP_MEMORY_SCOPE_AGENT); __hip_atomic_fetch_max(cp + 3, __float_as_uint(mx.w), __ATOMIC_RELAXED, __HIP_MEMORY_SCOPE_AGENT); } }
    asm volatile("s_waitcnt lgkmcnt(0)" ::: "memory");
    const int c = lane & 7;
#pragma unroll
    for (int j = 0; j < 4; ++j) { const int n = (lane >> 3) + 8 * j; const LAS float* s = scr + (8 * c) * 33 + n;
        u32x4 o; o.x = pk2(s[0 * 33], s[1 * 33]); o.y = pk2(s[2 * 33], s[3 * 33]); o.z = pk2(s[4 * 33], s[5 * 33]); o.w = pk2(s[6 * 33], s[7 * 33]);
        *(u32x4*)(WT + (size_t)(n0 + n) * K + k0 + 8 * c) = o; }
    asm volatile("s_waitcnt lgkmcnt(0)" ::: "memory");
}
__device__ __forceinline__ void comp_item(const float* w_in_l, const float* norm_g_l, const float* g_cq_l, const float* wu, int ldu, bf16* W1T_l, int nbase, int item, int lane, unsigned* cmax = nullptr) {
    const int jb = item >> 5, kb = item & 31, j0 = 32 * jb, k0 = 32 * kb;
    const int i = lane & 31, kk = lane >> 5;
    f32x16 acc = {};
    const float* ap = wu + (size_t)kk * ldu + j0 + i; const float* gp = g_cq_l + kk; const f32x4* bp4 = (const f32x4*)(w_in_l + (size_t)(k0 + i) * DIN + S_CQ);
#pragma unroll 1
    for (int s0 = 0; s0 < 128; s0 += 16) {
        float a[16]; f32x4 b4[8];
#pragma unroll
        for (int u = 0; u < 8; ++u) b4[u] = bp4[(s0 >> 1) + u];
#pragma unroll
        for (int u = 0; u < 16; ++u) { const int r2 = 2 * (s0 + u); a[u] = ap[(size_t)r2 * ldu] * gp[r2]; }
#pragma unroll
        for (int u = 0; u < 16; ++u) { const f32x4 q = b4[u >> 1]; const float bv = (u & 1) ? (kk ? q.w : q.z) : (kk ? q.y : q.x);
            acc = __builtin_amdgcn_mfma_f32_32x32x2f32(a[u], bv, acc, 0, 0, 0); }
    }
    const float gk = norm_g_l[k0 + i];
#pragma unroll
    for (int r = 0; r < 16; ++r) { const int j = (r & 3) + 8 * (r >> 2) + 4 * kk; const unsigned short hb = f2bf(acc[r] * gk);
        W1T_l[(size_t)(nbase + j0 + j) * 1024 + k0 + i] = (bf16)hb;
        if (cmax) {
            float m = fabsf(bf2f(hb));
#pragma unroll
            for (int o = 1; o < 32; o <<= 1) m = fmaxf(m, shx(m, o, lane));
            if (i == 0) __hip_atomic_fetch_max(cmax + nbase + j0 + j, __float_as_uint(m), __ATOMIC_RELAXED, __HIP_MEMORY_SCOPE_AGENT); } }
}

__device__ __forceinline__ unsigned q8(float v) { int i = (int)rintf(v); i = i < -127 ? -127 : (i > 127 ? 127 : i); return (unsigned)i & 255u; }
__device__ __forceinline__ unsigned pk4q(float a, float b, float c_, float d) { return q8(a) | (q8(b) << 8) | (q8(c_) << 16) | (q8(d) << 24); }
__device__ __forceinline__ void p0_prologue_b(Ctx& c) {
    for (int l = 0; l < 2; ++l) {
        const unsigned* cm = (const unsigned*)(c.ws + WS_CTL) + CW_CMAX + l * N1;
        const bf16* W1T_l = (const bf16*)(c.ws + WS_W1T) + (size_t)l * N1 * 1024; unsigned char* WQ = c.ws + WS_W1Q + (size_t)l * N1 * 1024;
        for (int nb = c.gw; nb < N1; nb += 2 * c.NGW) {
            const int n0 = nb, n1 = nb + c.NGW;
            const bool ok0 = !(n0 >= C_QI && n0 < C_Z), ok1 = n1 < N1 && !(n1 >= C_QI && n1 < C_Z);
            unsigned m0 = 0u, m1 = 0u; u32x4 a0 = {}, b0 = {}, a1 = {}, b1 = {};
            if (ok0) { m0 = cm[n0]; const u32x4* xp = (const u32x4*)(W1T_l + (size_t)n0 * 1024) + 2 * c.lane; a0 = xp[0]; b0 = xp[1]; }
            if (ok1) { m1 = cm[n1]; const u32x4* xp = (const u32x4*)(W1T_l + (size_t)n1 * 1024) + 2 * c.lane; a1 = xp[0]; b1 = xp[1]; }
#define P0B_ROW(ok_, n_, m_, a_, b_) if (ok_) { \
            const unsigned sb = (__float_as_uint(__uint_as_float(m_) * (1.0f / 127.0f)) + 0xFFFFu) >> 16;       \
            const float sc = __uint_as_float(sb << 16), inv = sc > 0.f ? 1.0f / sc : 0.f; \
            if (c.lane == 0) ((unsigned short*)((unsigned*)(c.ws + WS_CTL) + CW_CS16))[l * N1 + (n_)] = (unsigned short)sb; \
            u32x4 o; \
            o.x = pk4q(bflo(a_.x) * inv, bfhi(a_.x) * inv, bflo(a_.y) * inv, bfhi(a_.y) * inv); o.y = pk4q(bflo(a_.z) * inv, bfhi(a_.z) * inv, bflo(a_.w) * inv, bfhi(a_.w) * inv); \
            o.z = pk4q(bflo(b_.x) * inv, bfhi(b_.x) * inv, bflo(b_.y) * inv, bfhi(b_.y) * inv); o.w = pk4q(bflo(b_.z) * inv, bfhi(b_.z) * inv, bflo(b_.w) * inv, bfhi(b_.w) * inv); \
            *((u32x4*)(WQ + (size_t)(n_) * 1024) + c.lane) = o; }
            P0B_ROW(ok0, n0, m0, a0, b0) P0B_ROW(ok1, n1, m1, a1, b1)
#undef P0B_ROW
        }
    }
}
__device__ __forceinline__ void p0_prologue(Ctx& c) {
    LAS float* scr = (LAS float*)(c.lds + c.wave * 16384);
    for (int l = 0; l < 2; ++l) {
        const float* w_in_l = P_WIN(c) + (size_t)l * D * DIN; const float* ng = P_NORMG(c) + l * D;
        bf16* W1T_l = (bf16*)(c.ws + WS_W1T) + (size_t)l * N1 * 1024;
        for (int it = c.gw; it < 16 * (N1 / 32); it += c.NGW) {
            const int nb = it % (N1 / 32);
            if (nb * 32 >= C_QB && nb * 32 < C_CKV) continue;
            tr_item(w_in_l, DIN, ng, W1T_l, 1024, N1 / 32, it, scr, c.lane, [](int n) { return src_col(n); }, (unsigned*)(c.ws + WS_CTL) + CW_CMAX + l * N1);
        }
        for (int it = c.gw; it < 16 * 32; it += c.NGW) comp_item(w_in_l, ng, P_GCQ(c) + l * 256, P_WUQ(c) + (size_t)l * 256 * 512, 512, W1T_l, C_QB, it, c.lane, (unsigned*)(c.ws + WS_CTL) + CW_CMAX + l * N1);
        for (int it = c.gw; it < 8 * 32; it += c.NGW) comp_item(w_in_l, ng, P_GCQ(c) + l * 256, P_WUQI(c) + (size_t)l * 256 * 256, 256, W1T_l, C_QI, it, c.lane);
        for (int it = c.gw; it < 8 * 32; it += c.NGW) tr_item(P_WA(c) + (size_t)l * 512 * 1024, 1024, nullptr, (bf16*)(c.ws + WS_WAT) + (size_t)l * 1024 * 512, 512, 32, it, scr, c.lane, [](int n) { return n; });
        for (int it = c.gw; it < 8 * 32; it += c.NGW) tr_item(P_WB(c) + (size_t)l * 512 * 1024, 1024, nullptr, (bf16*)(c.ws + WS_WBT) + (size_t)l * 1024 * 512, 512, 32, it, scr, c.lane, [](int n) { return n; });
        for (int it = c.gw; it < 12 * 32; it += c.NGW) tr_item(P_WC(c) + (size_t)l * 768 * 1024, 1024, nullptr, (bf16*)(c.ws + WS_WCT) + (size_t)l * 1024 * 768, 768, 32, it, scr, c.lane, [](int n) { return n; });
        for (int it = c.gw; it < 16 * 32; it += c.NGW) tr_item(P_WO(c) + (size_t)l * 1024 * 1024, 1024, nullptr, (bf16*)(c.ws + WS_WOT) + (size_t)l * 1024 * 1024, 1024, 32, it, scr, c.lane, [](int n) { return n; });
        for (int it = c.gw; it < 2 * 4; it += c.NGW) tr_item(P_WUKV(c) + (size_t)l * 128 * 128, 128, P_GCKV(c) + l * 128, (bf16*)(c.ws + WS_WKVT) + (size_t)l * 128 * 128, 128, 4, it, scr, c.lane, [](int n) { return n; });
    }
    bf16* XB = (bf16*)(c.ws + WS_XB); unsigned long long* SSQ = (unsigned long long*)(c.ws + WS_SSQ);
    for (int m0 = c.gw * 4; m0 < MALL; m0 += c.NGW * 4) {
        f32x4 v[4][4];
#pragma unroll
        for (int r = 0; r < 4; ++r) { const f32x4* xr = (const f32x4*)(P_X(c) + (size_t)(m0 + r) * D) + c.lane;
#pragma unroll
            for (int j = 0; j < 4; ++j) v[r][j] = xr[64 * j]; }
#pragma unroll
        for (int r = 0; r < 4; ++r) { float s = 0.f; unsigned long long* o8 = (unsigned long long*)(XB + (size_t)(m0 + r) * D) + c.lane;
#pragma unroll
            for (int j = 0; j < 4; ++j) { const f32x4 q = v[r][j]; s += (q.x * q.x + q.y * q.y) + (q.z * q.z + q.w * q.w);
                o8[64 * j] = (unsigned long long)pk2(q.x, q.y) | ((unsigned long long)pk2(q.z, q.w) << 32); }
            s = wave_sum(s, c.lane);
            if (c.lane == 0) { SSQ[m0 + r] = (unsigned long long)(s * SSQ_SCALE + 0.5f); SSQ[MALL + m0 + r] = 0ull; SSQ[2 * MALL + m0 + r] = 0ull; }
            const float qs = __builtin_amdgcn_rsqf(s * (1.0f / D) + EPS) * XQ_SCALE; unsigned* xq = (unsigned*)(c.ws + WS_XQ + (size_t)(m0 + r) * 1024) + c.lane;
#pragma unroll
            for (int j = 0; j < 4; ++j) { const f32x4 q = v[r][j] * qs; xq[64 * j] = pk4q(q.x, q.y, q.z, q.w); } }
    }
}

__device__ __forceinline__ void st_bf4(bf16* p, f32x4 v) { *(u32x2*)p = (u32x2){pk2(v.x, v.y), pk2(v.z, v.w)}; }
__device__ __forceinline__ int perm_row(int row, int grp) {
    if (grp == 0) return row;
    const int b = row >> 11, t = row & 2047;
    return grp == 1 ? (b << 11) + ((t & 3) << 9) + (t >> 2) : (b << 11) + ((t & 15) << 7) + (t >> 4);
}
__device__ __forceinline__ float row_rstd(const unsigned long long* SSQ, int grow) {
    const float s = (float)SSQ[grow] * (1.0f / SSQ_SCALE);
    return __builtin_amdgcn_rsqf(s * (1.0f / D) + EPS);
}

namespace pg8 {
constexpr int BM = 256, BK = 64, HALF = 128, HTB = HALF * BK * 2, STAGE_BYTES = 8 * HTB, NXCD = 8, WGM = 8;
__host__ __device__ __forceinline__ int lds_byte(int r, int c) { const int st = (r >> 4) * 2 + (c >> 5), rr = r & 15, cc = c & 31, ob = rr * 64 + cc * 2; return st * 1024 + (ob ^ (((ob >> 9) & 1) << 5)); }
__host__ __device__ __forceinline__ void stage_rc(int b, int& R, int& C) { const int st = b / 1024, sb = b % 1024, swz = sb ^ (((sb >> 9) & 1) << 5); R = (st >> 1) * 16 + swz / 64; C = (st & 1) * 32 + (swz % 64) / 2; }
__host__ __device__ __forceinline__ int perm32(int rho) { const int n = rho >> 4, i = rho & 15; return 8 * (i >> 2) + 4 * n + (i & 3); }
struct Unit { int pm, pn; const char* A; const char* B; int lda, ldb, nt, aux; };
__device__ __forceinline__ unsigned cvt_pk_bf16(float lo, float hi) { unsigned r; asm volatile("v_cvt_pk_bf16_f32 %0, %1, %2" : "=v"(r) : "v"(lo), "v"(hi)); return r; }
__device__ __forceinline__ void glds2(const char* sbase, unsigned v0, unsigned v1, unsigned d0) { const unsigned d1 = d0 + 8192u;
    asm volatile("s_mov_b32 m0, %3\n\ts_nop 0\n\tglobal_load_lds_dwordx4 %1, %0\n\ts_mov_b32 m0, %4\n\ts_nop 0\n\tglobal_load_lds_dwordx4 %2, %0"
                 :: "s"(sbase), "v"(v0), "v"(v1), "s"(d0), "s"(d1) : "memory"); }
__device__ __forceinline__ bool tile_order(int nM, int nN, int G, int c, int i, int& pm, int& pn) {
    const int nwg = nM * nN; const long L = (long)i * G + c; if (L >= nwg) return false;
    int wgid = (int)L; { const int q = nwg / NXCD, r = nwg % NXCD, xcd = wgid % NXCD, off = wgid / NXCD; wgid = (xcd < r ? xcd * (q + 1) : r * (q + 1) + (xcd - r) * q) + off; }
    const int nig = WGM * nN, gid = wgid / nig, fm = gid * WGM, gsz = (nM - fm) < WGM ? (nM - fm) : WGM;
    pm = fm + ((wgid % nig) % gsz); pn = (wgid % nig) / gsz; return true;
}
template <class Epi, class Sched, bool ALIGN_EPI = true, bool I8 = false>
__device__ __forceinline__ void gemm_phase(LAS unsigned char* lds, const Sched& S, const Epi& E, int tid_in) {
    const int tid = tid_in, wid = __builtin_amdgcn_readfirstlane(tid >> 6), lane = tid & 63, wr = wid >> 2, wc = wid & 3, fr = lane & 15, fq = lane >> 4;
    int sR[2], sC[2], sRb[2];
#pragma unroll
    for (int i = 0; i < 2; ++i) { int R, C; stage_rc(tid * 16 + i * 8192, R, C); sR[i] = R; sC[i] = C; sRb[i] = Epi::PERM ? ((R & ~31) + perm32(R & 31)) : R; }
    const size_t kstep = (size_t)(BK * 2);
    const unsigned ldsb = (unsigned)__builtin_amdgcn_readfirstlane((int)((unsigned)(uintptr_t)lds + (unsigned)wid * 1024u));
    const int aoff = lds_byte(wr * 64 + fr, fq * 8), boff = lds_byte(wc * 32 + fr, fq * 8);
#define PG8_SA(b, h) (((b) * 2 + (h)) * HTB)
#define PG8_SB(b, h) ((4 + (b) * 2 + (h)) * HTB)
#define PG8_STAGE(bufoff, gbase, voff) pg8::glds2((const char*)(gbase), (voff)[0], (voff)[1], ldsb + (unsigned)(bufoff))
#define PG8_LDA(dst, b, h) do { _Pragma("unroll") for (int m = 0; m < 4; ++m) _Pragma("unroll") for (int k = 0; k < 2; ++k) dst[m][k] = *(const LAS bf16x8*)(lds + PG8_SA(b, h) + aoff + m * 2048 + k * 1024); } while (0)
#define PG8_LDB(dst, b, h) do { _Pragma("unroll") for (int n = 0; n < 2; ++n) _Pragma("unroll") for (int k = 0; k < 2; ++k) dst[n][k] = *(const LAS bf16x8*)(lds + PG8_SB(b, h) + boff + n * 2048 + k * 1024); } while (0)
#define PG8_MMA(ai, bj, At, Bt) do { __builtin_amdgcn_s_setprio(1); _Pragma("unroll") for (int m = 0; m < 4; ++m) _Pragma("unroll") for (int n = 0; n < 2; ++n) _Pragma("unroll") for (int k = 0; k < 2; ++k) { \
        if constexpr (I8) acc[ai][bj][m][n] = __builtin_bit_cast(f32x4, __builtin_amdgcn_mfma_i32_16x16x64_i8(__builtin_bit_cast(i32x4, Bt[n][k]), __builtin_bit_cast(i32x4, At[m][k]), __builtin_bit_cast(i32x4, acc[ai][bj][m][n]), 0, 0, 0)); \
        else acc[ai][bj][m][n] = __builtin_amdgcn_mfma_f32_16x16x32_bf16(Bt[n][k], At[m][k], acc[ai][bj][m][n], 0, 0, 0); } __builtin_amdgcn_s_setprio(0); } while (0)
#define PG8_WAIT_V(n) asm volatile("s_waitcnt vmcnt(" #n ")" ::: "memory")
#define PG8_WAIT_L(n) asm volatile("s_waitcnt lgkmcnt(" #n ")" ::: "memory")
#define PG8_WAIT_VR do { if (rl) PG8_WAIT_V(24); else PG8_WAIT_V(8); } while (0)
#define PG8_BAR __builtin_amdgcn_s_barrier()
#define PG8_SCHED __builtin_amdgcn_sched_barrier(0)
#define PG8_VOFF(u, va, vb) do { _Pragma("unroll") for (int _i = 0; _i < 2; ++_i) { va[_i] = (unsigned)(sR[_i] * (u).lda + sC[_i]) * 2u; vb[_i] = (unsigned)(sRb[_i] * (u).ldb + sC[_i]) * 2u; } } while (0)
    Unit cur, nxt; int ui = 0;
    if (!S.next(0, cur)) return;
    __builtin_amdgcn_s_waitcnt(0x0F70);
    f32x4 acc[2][2][4][2];
#pragma unroll
    for (int a = 0; a < 2; ++a)
#pragma unroll
        for (int b = 0; b < 2; ++b)
#pragma unroll
            for (int m = 0; m < 4; ++m)
#pragma unroll
                for (int n = 0; n < 2; ++n) acc[a][b][m][n] = (f32x4){0.f, 0.f, 0.f, 0.f};
    bf16x8 At[4][2], B0[2][2], B1[2][2];
    unsigned voffA[2], voffB[2], nvoffA[2], nvoffB[2];
    PG8_VOFF(cur, voffA, voffB);
    const char* cA = cur.A; const char* cB = cur.B;
    size_t hsA = (size_t)HALF * cur.lda * 2, hsB = (size_t)HALF * cur.ldb * 2;
    {
        PG8_STAGE(PG8_SB(0, 0), cB, voffB); PG8_STAGE(PG8_SB(0, 1), cB + hsB, voffB); PG8_STAGE(PG8_SA(0, 0), cA, voffA); PG8_STAGE(PG8_SA(0, 1), cA + hsA, voffA);
        if (wr == 1) PG8_BAR;
        PG8_WAIT_V(2); PG8_BAR;
        PG8_STAGE(PG8_SB(1, 0), cB + kstep, voffB); PG8_STAGE(PG8_SA(1, 0), cA + kstep, voffA); PG8_STAGE(PG8_SB(1, 1), cB + hsB + kstep, voffB); PG8_STAGE(PG8_SA(1, 1), cA + hsA + kstep, voffA);
        PG8_WAIT_V(0); PG8_BAR;
    }
    typename Epi::Pre pre;
    for (;;) {
        E.pre(pre, cur, wr, wc, fr, fq);
        const bool has_next = S.next(ui + 1, nxt);
        if (!has_next) nxt = cur;
        const char* nA = nxt.A; const char* nB = nxt.B;
        PG8_VOFF(nxt, nvoffA, nvoffB);
        const size_t nhsA = (size_t)HALF * nxt.lda * 2, nhsB = (size_t)HALF * nxt.ldb * 2;
        const int nt = cur.nt;
        for (int t = 0; t < nt; t += 2) {
            const bool last = (t == nt - 2);
            const char* a2 = last ? nA : cA + (size_t)(t + 2) * kstep; const char* b2 = last ? nB : cB + (size_t)(t + 2) * kstep;
            const char* a3 = a2 + kstep; const char* b3 = b2 + kstep;
            const size_t hA2 = last ? nhsA : hsA, hB2 = last ? nhsB : hsB;
            unsigned vA2[2], vB2[2];
#pragma unroll
            for (int _i = 0; _i < 2; ++_i) { vA2[_i] = last ? nvoffA[_i] : voffA[_i]; vB2[_i] = last ? nvoffB[_i] : voffB[_i]; }
            const bool rl = (t == 0);
            PG8_LDB(B0, 0, 0); PG8_LDB(B1, 0, 1); PG8_SCHED; PG8_LDA(At, 0, 0);
            PG8_WAIT_VR; PG8_WAIT_L(0); PG8_BAR; PG8_MMA(0, 0, At, B0); PG8_MMA(0, 1, At, B1); PG8_BAR; PG8_SCHED;
            PG8_LDA(At, 0, 1); PG8_STAGE(PG8_SB(0, 0), b2, vB2); PG8_STAGE(PG8_SB(0, 1), b2 + hB2, vB2); PG8_STAGE(PG8_SA(0, 0), a2, vA2);
            PG8_WAIT_VR; PG8_WAIT_L(0); PG8_BAR; PG8_MMA(1, 0, At, B0); PG8_MMA(1, 1, At, B1); PG8_BAR; PG8_SCHED;
            PG8_LDB(B0, 1, 0); PG8_LDB(B1, 1, 1); PG8_SCHED; PG8_LDA(At, 1, 0); PG8_STAGE(PG8_SA(0, 1), a2 + hA2, vA2);
            PG8_WAIT_VR; PG8_WAIT_L(0); PG8_BAR; PG8_MMA(0, 0, At, B0); PG8_MMA(0, 1, At, B1); PG8_BAR; PG8_SCHED;
            PG8_LDA(At, 1, 1); PG8_STAGE(PG8_SB(1, 0), b3, vB2); PG8_STAGE(PG8_SB(1, 1), b3 + hB2, vB2); PG8_STAGE(PG8_SA(1, 0), a3, vA2);
            PG8_WAIT_V(8); PG8_WAIT_L(0); PG8_BAR; PG8_MMA(1, 0, At, B0); PG8_MMA(1, 1, At, B1); PG8_BAR; PG8_SCHED;
            PG8_STAGE(PG8_SA(1, 1), a3 + hA2, vA2);
        }
        if constexpr (ALIGN_EPI) { if (wr == 0) PG8_BAR; }
        E(acc, cur, wr, wc, fr, fq, pre);
        if (!has_next) break;
        if (!(Epi::CHAIN && nxt.aux != 0)) {
#pragma unroll
        for (int a = 0; a < 2; ++a)
#pragma unroll
            for (int b = 0; b < 2; ++b)
#pragma unroll
                for (int m = 0; m < 4; ++m)
#pragma unroll
                    for (int n = 0; n < 2; ++n) acc[a][b][m][n] = (f32x4){0.f, 0.f, 0.f, 0.f};
        }
        cur = nxt; cA = nA; cB = nB; hsA = nhsA; hsB = nhsB; ++ui;
#pragma unroll
        for (int _i = 0; _i < 2; ++_i) { voffA[_i] = nvoffA[_i]; voffB[_i] = nvoffB[_i]; }
        if constexpr (ALIGN_EPI) { if (wr == 1) PG8_BAR; }
    }
    PG8_WAIT_V(0);
    if constexpr (!ALIGN_EPI) { if (wr == 0) PG8_BAR; }
    PG8_BAR;
#undef PG8_SA
#undef PG8_SB
#undef PG8_STAGE
#undef PG8_LDA
#undef PG8_LDB
#undef PG8_MMA
#undef PG8_WAIT_V
#undef PG8_WAIT_VR
#undef PG8_WAIT_L
#undef PG8_BAR
#undef PG8_SCHED
#undef PG8_VOFF
}
}

struct UniSched {
    const char* A; const char* B; int lda, ldb, nt, nM, nN, G, cid;
    __device__ __forceinline__ bool next(int i, pg8::Unit& u) const {
        int pm, pn; if (!pg8::tile_order(nM, nN, G, cid, i, pm, pn)) return false;
        u.pm = pm; u.pn = pn; u.A = A + (size_t)pm * 256 * lda * 2; u.B = B + (size_t)pn * 256 * ldb * 2; u.lda = lda; u.ldb = ldb; u.nt = nt; u.aux = 0; return true;
    }
};
struct SubSched {
    const char* A; const char* B; int lda, ldb, nt, nM, nN, G, cid, split, skip;
    __device__ __forceinline__ bool next(int i, pg8::Unit& u) const {
        int pm, pl; if (!pg8::tile_order(nM, nN, G, cid, i, pm, pl)) return false;
        const int pn = pl < split ? pl : pl + skip;
        u.pm = pm; u.pn = pn; u.A = A + (size_t)pm * 256 * lda * 2; u.B = B + (size_t)pn * 256 * ldb * 2; u.lda = lda; u.ldb = ldb; u.nt = nt; u.aux = 0; return true;
    }
};
__device__ __forceinline__ u32x4 pack8(f32x4 a, f32x4 b) { u32x4 w; w.x = pg8::cvt_pk_bf16(a.x, a.y); w.y = pg8::cvt_pk_bf16(a.z, a.w); w.z = pg8::cvt_pk_bf16(b.x, b.y); w.w = pg8::cvt_pk_bf16(b.z, b.w); return w; }
__device__ __forceinline__ f32x4 sig4(f32x4 v) { return (f32x4){sigmoidf_(v.x), sigmoidf_(v.y), sigmoidf_(v.z), sigmoidf_(v.w)}; }
__device__ __forceinline__ f32x4 silu4(f32x4 v) { return (f32x4){siluf_(v.x), siluf_(v.y), siluf_(v.z), siluf_(v.w)}; }
template <bool I8> struct EpiP1 {
    static constexpr bool PERM = true, CHAIN = false;
    unsigned char* ws; int row0, layer; LAS unsigned char* lds;
    struct Pre {}; __device__ __forceinline__ void pre(Pre&, const pg8::Unit&, int, int, int, int) const {}
    __device__ __forceinline__ int operator()(const f32x4 (&acc)[2][2][4][2], const pg8::Unit& u, int wr, int wc, int fr, int fq, const Pre&) const {
        asm volatile("" : "+v"(fr), "+v"(fq));
        const int rowb = u.pm * 256 + wr * 64 + fr, pn = u.pn, cl = wc * 32 + 8 * fq;
        const unsigned long long* SSQ = (const unsigned long long*)(ws + WS_SSQ) + (size_t)layer * MALL;
        float rs[2][4]; f32x4 cs[2][2];
        if constexpr (I8) {
#pragma unroll
            for (int ai = 0; ai < 2; ++ai)
#pragma unroll
                for (int m = 0; m < 4; ++m) rs[ai][m] = 1.0f;
        } else {
            unsigned long long q0 = SSQ[row0 + rowb], q1 = SSQ[row0 + rowb + 16], q2 = SSQ[row0 + rowb + 32], q3 = SSQ[row0 + rowb + 48],
                               q4 = SSQ[row0 + rowb + 128], q5 = SSQ[row0 + rowb + 144], q6 = SSQ[row0 + rowb + 160], q7 = SSQ[row0 + rowb + 176];
            asm volatile("" : "+v"(q0), "+v"(q1), "+v"(q2), "+v"(q3), "+v"(q4), "+v"(q5), "+v"(q6), "+v"(q7));
            const unsigned long long q[8] = {q0, q1, q2, q3, q4, q5, q6, q7};
#pragma unroll
            for (int ai = 0; ai < 2; ++ai)
#pragma unroll
                for (int m = 0; m < 4; ++m) rs[ai][m] = __builtin_amdgcn_rsqf((float)q[ai * 4 + m] * (1.0f / SSQ_SCALE) * (1.0f / D) + EPS);
        }
        if constexpr (I8) { const LAS unsigned short* cm = (const LAS unsigned short*)(lds + L_CS16) + pn * 256 + cl;
#pragma unroll
            for (int bj = 0; bj < 2; ++bj) { const u32x4 q = *(const LAS u32x4*)(cm + bj * 128); const float k_ = XCLIP / 127.0f;
                cs[bj][0] = (f32x4){bflo(q.x) * k_, bfhi(q.x) * k_, bflo(q.y) * k_, bfhi(q.y) * k_}; cs[bj][1] = (f32x4){bflo(q.z) * k_, bfhi(q.z) * k_, bflo(q.w) * k_, bfhi(q.w) * k_}; } }
#define P1V(ai, bj, m, n) (I8 ? __builtin_convertvector(__builtin_bit_cast(i32x4, acc[ai][bj][m][n]), f32x4) * cs[bj][n] : acc[ai][bj][m][n])
#define P1W(ai, bj, m, n, r_) (I8 ? __builtin_convertvector(__builtin_bit_cast(i32x4, acc[ai][bj][m][n]), f32x4) * cs[bj][n] : acc[ai][bj][m][n] * (r_))
        unsigned char* ch = ws + WS_CH;
        if (I8 && pn == 15) {
            float* SSQC = (float*)(ch + O_SSQC); float* SSQD = (float*)(ws + WS_PAD16);
#pragma unroll
            for (int ai = 0; ai < 2; ++ai)
#pragma unroll
                for (int m = 0; m < 4; ++m) { float s = 0.f;
#pragma unroll
                    for (int bj = 0; bj < 2; ++bj)
#pragma unroll
                        for (int n = 0; n < 2; ++n) { const f32x4 v = P1V(ai, bj, m, n) * rs[ai][m]; s += (v.x * v.x + v.y * v.y) + (v.z * v.z + v.w * v.w); }
                    s += shx(s, 16, fr + 16 * fq); s += shx(s, 32, fr + 16 * fq);
                    if (fq == 0) { SSQC[(size_t)(rowb + ai * 128 + m * 16) * 8 + wc] = s; SSQD[(size_t)(rowb + ai * 128 + m * 16) * 8 + wc] = s; } }
            return 16;
        }
        if (!I8 && pn == 19) {
            float* SSQC = (float*)(ch + O_SSQC); bf16* CKV = (bf16*)(ch + O_CKV); bf16* KI = (bf16*)(ch + O_KI); float* WF = (float*)(ch + O_WF);
#pragma unroll
            for (int ai = 0; ai < 2; ++ai)
#pragma unroll
                for (int m = 0; m < 4; ++m) { const int row = rowb + ai * 128 + m * 16; const float r = rs[ai][m];
                    const f32x4 v0 = P1V(ai, 0, m, 0) * r, v1 = P1V(ai, 0, m, 1) * r;
                    *(u32x4*)(CKV + (size_t)row * 128 + cl) = pack8(v0, v1);
                    float s = ((v0.x * v0.x + v0.y * v0.y) + (v0.z * v0.z + v0.w * v0.w)) + ((v1.x * v1.x + v1.y * v1.y) + (v1.z * v1.z + v1.w * v1.w));
                    s += shx(s, 16, fr + 16 * fq); s += shx(s, 32, fr + 16 * fq);
                    if (fq == 0) SSQC[(size_t)row * 8 + 4 + wc] = s;
                    const f32x4 w0 = P1V(ai, 1, m, 0) * r, w1 = P1V(ai, 1, m, 1) * r;
                    if (wc == 0) *(u32x4*)(KI + (size_t)row * 32 + 8 * fq) = pack8(w0, w1);
                    else if (wc == 1 && fq < 2) { *(f32x4*)(WF + (size_t)row * 16 + 8 * fq) = w0; *(f32x4*)(WF + (size_t)row * 16 + 8 * fq + 4) = w1; } }
            return 16;
        }
        bf16* dst; int ld, cb, act = 0, lg = 0; float sc = 1.f;
        if (pn < 6) { dst = (bf16*)(ch + O_QKVA); ld = 1536; cb = pn * 256; if (pn < 2) sc = QS; }
        else if (pn < 15) { dst = (bf16*)(ch + O_QKVC); ld = 2304; cb = (pn - 6) * 256; lg = 2 * ((pn - 6) % 3); if (pn < 9) sc = QS; }
        else if (pn < 18) { dst = (bf16*)(ch + O_QB); ld = 512; cb = (pn - 16) * 256; sc = QS; }
        else if (pn == 18) { dst = (bf16*)(ch + O_QI); ld = 256; cb = 0; }
        else if (pn < 27) { dst = (bf16*)(ch + O_ZY); ld = 1792; cb = (pn - 20) * 256; act = 1; }
        else { dst = (bf16*)(ch + O_G); ld = 3072; cb = (pn - 27) * 256; act = 2; }
        if constexpr (I8) { if (sc != 1.f) {
#pragma unroll
            for (int bj = 0; bj < 2; ++bj)
#pragma unroll
                for (int n = 0; n < 2; ++n) cs[bj][n] = cs[bj][n] * sc; } }
#define P1_BODY(ACT) do { _Pragma("unroll") for (int ai = 0; ai < 2; ++ai) _Pragma("unroll") for (int m = 0; m < 4; ++m) { \
                const int row = rowb + ai * 128 + m * 16; const float r = rs[ai][m] * sc; const int b_ = row >> 11, t_ = row & 2047; \
                const int prow = (b_ << 11) + ((t_ & ((1 << lg) - 1)) << (11 - lg)) + (t_ >> lg); \
                bf16* rp = dst + (size_t)prow * ld + cb + cl; \
                _Pragma("unroll") for (int bj = 0; bj < 2; ++bj) { f32x4 v0 = P1W(ai, bj, m, 0, r), v1 = P1W(ai, bj, m, 1, r); \
                    if (ACT == 2) {     \
                        v0 = sig4(v0) * 255.0f + 0.5f; v1 = sig4(v1) * 255.0f + 0.5f; \
                        v0.x = fmaxf(v0.x, 1.f); v0.y = fmaxf(v0.y, 1.f); v0.z = fmaxf(v0.z, 1.f); v0.w = fmaxf(v0.w, 1.f); v1.x = fmaxf(v1.x, 1.f); v1.y = fmaxf(v1.y, 1.f); v1.z = fmaxf(v1.z, 1.f); v1.w = fmaxf(v1.w, 1.f); \
                        const unsigned lo = (unsigned)v0.x | ((unsigned)v0.y << 8) | ((unsigned)v0.z << 16) | ((unsigned)v0.w << 24), hi_ = (unsigned)v1.x | ((unsigned)v1.y << 8) | ((unsigned)v1.z << 16) | ((unsigned)v1.w << 24); \
                        *(u32x2*)((unsigned char*)(ch + O_G) + (size_t)row * 3072 + cb + cl + bj * 128) = (u32x2){lo, hi_}; } \
                    else { if (ACT == 1) { v0 = silu4(v0); v1 = silu4(v1); } \
                        *(u32x4*)(rp + bj * 128) = pack8(v0, v1); } } } } while (0)
        if (act == 0) P1_BODY(0); else if (act == 1) P1_BODY(1); else P1_BODY(2);
#undef P1_BODY
        return 16;
    }
};
#undef P1V
#undef P1W
struct EpiOut {
    static constexpr bool PERM = true, CHAIN = false;
    unsigned char* ws; int row0; int layer;
    struct Pre {}; __device__ __forceinline__ void pre(Pre&, const pg8::Unit&, int, int, int, int) const {}
    __device__ __forceinline__ int operator()(const f32x4 (&acc)[2][2][4][2], const pg8::Unit& u, int wr, int wc, int fr, int fq, const Pre&) const {
        asm volatile("" : "+v"(fr), "+v"(fq));
        const int rowb = row0 + u.pm * 256 + wr * 64 + fr, cl = u.pn * 256 + wc * 32 + 8 * fq;
        bf16* XB = (bf16*)(ws + WS_XB) + cl; unsigned long long* SSQ1 = (unsigned long long*)(ws + WS_SSQ) + (size_t)(layer + 1) * MALL;
        u32x4 xo[2][4][2];
#pragma unroll
        for (int ai = 0; ai < 2; ++ai)
#pragma unroll
            for (int m = 0; m < 4; ++m) { const bf16* xp = XB + (size_t)(rowb + ai * 128 + m * 16) * D; xo[ai][m][0] = *(const u32x4*)xp; xo[ai][m][1] = *(const u32x4*)(xp + 128); }
        asm volatile("" : "+v"(xo[0][0][0]), "+v"(xo[0][0][1]), "+v"(xo[0][1][0]), "+v"(xo[0][1][1]), "+v"(xo[0][2][0]), "+v"(xo[0][2][1]), "+v"(xo[0][3][0]), "+v"(xo[0][3][1]),
                          "+v"(xo[1][0][0]), "+v"(xo[1][0][1]), "+v"(xo[1][1][0]), "+v"(xo[1][1][1]), "+v"(xo[1][2][0]), "+v"(xo[1][2][1]), "+v"(xo[1][3][0]), "+v"(xo[1][3][1]));
#pragma unroll
        for (int ai = 0; ai < 2; ++ai) {
#pragma unroll
            for (int m = 0; m < 4; ++m) { const int row = rowb + ai * 128 + m * 16; bf16* xp = XB + (size_t)row * D; float s = 0.f;
#pragma unroll
                for (int bj = 0; bj < 2; ++bj) { const u32x4 x4 = xo[ai][m][bj];
                    const f32x4 a = (f32x4){bflo(x4.x), bfhi(x4.x), bflo(x4.y), bfhi(x4.y)} + acc[ai][bj][m][0], b = (f32x4){bflo(x4.z), bfhi(x4.z), bflo(x4.w), bfhi(x4.w)} + acc[ai][bj][m][1];
                    *(u32x4*)(xp + bj * 128) = pack8(a, b);
                    s += ((a.x * a.x + a.y * a.y) + (a.z * a.z + a.w * a.w)) + ((b.x * b.x + b.y * b.y) + (b.z * b.z + b.w * b.w)); }
                s += shx(s, 16, fr + 16 * fq); s += shx(s, 32, fr + 16 * fq);
                if (fq == 0) __hip_atomic_fetch_add(SSQ1 + row, (unsigned long long)(s * SSQ_SCALE + 0.5f), __ATOMIC_RELAXED, __HIP_MEMORY_SCOPE_AGENT); }
        }
        return 16;
    }
};


struct MrgSched {
    unsigned char* ws; int layer, nM, nN, G, cid;
    __device__ __forceinline__ bool next(int i, pg8::Unit& u) const {
        const int tile = i / 3, which = i - 3 * tile; int pm, pn; if (!pg8::tile_order(nM, nN, G, cid, tile, pm, pn)) return false;
        u.pm = pm; u.pn = pn; u.lda = 1792; u.ldb = which == 2 ? 768 : 512; u.nt = u.ldb / 64; u.aux = which;
        u.A = (const char*)(ws + WS_CH + O_ZY) + ((size_t)pm * 256 * 1792 + (which == 0 ? 0 : (which == 1 ? 512 : 1024))) * 2;
        const size_t wbase = which == 0 ? WS_WAT + (size_t)layer * 1024 * 512 * 2 : (which == 1 ? WS_WBT + (size_t)layer * 1024 * 512 * 2 : WS_WCT + (size_t)layer * 1024 * 768 * 2);
        u.B = (const char*)(ws + wbase) + (size_t)pn * 256 * u.ldb * 2; return true;
    }
};
struct EpiMrg {
    static constexpr bool PERM = true, CHAIN = true;
    unsigned char* ws;
    struct Pre { u32x2 w0, w1, n0, n1, w2, w3, n2, n3; };
    __device__ __forceinline__ void pre(Pre& p, const pg8::Unit& u, int wr, int wc, int fr, int fq) const {
        const unsigned char* g = (const unsigned char*)(ws + WS_CH + O_G) + u.aux * 1024 + u.pn * 256 + wc * 32 + 8 * fq + (size_t)(u.pm * 256 + wr * 64 + fr) * 3072;
        p.w0 = *(const u32x2*)g; p.w1 = *(const u32x2*)(g + 128); p.w2 = *(const u32x2*)(g + 16 * 3072); p.w3 = *(const u32x2*)(g + 16 * 3072 + 128);
        if (u.aux < 2) { p.n0 = *(const u32x2*)(g + 1024); p.n1 = *(const u32x2*)(g + 1024 + 128); p.n2 = *(const u32x2*)(g + 16 * 3072 + 1024); p.n3 = *(const u32x2*)(g + 16 * 3072 + 1024 + 128); }
        else { p.n0 = p.w0; p.n1 = p.w1; p.n2 = p.w2; p.n3 = p.w3; }
    }
    __device__ __forceinline__ int operator()(f32x4 (&acc)[2][2][4][2], const pg8::Unit& u, int wr, int wc, int fr, int fq, const Pre& pr) const {
        asm volatile("" : "+v"(fr), "+v"(fq));
        const int which = u.aux, rowb = u.pm * 256 + wr * 64 + fr, cl = u.pn * 256 + wc * 32 + 8 * fq;
        const unsigned char* Gb = (const unsigned char*)(ws + WS_CH + O_G) + which * 1024 + cl; bf16* MRG = (bf16*)(ws + WS_CH + O_MRG) + cl;
        u32x2 gw[8][2], gn[8][2];
#define MRG_LOAD(g_, MID) do { const int row_ = rowb + ((g_) >> 2) * 128 + ((g_) & 3) * 16; \
        gw[g_][0] = *(const u32x2*)(Gb + (size_t)row_ * 3072); gw[g_][1] = *(const u32x2*)(Gb + (size_t)row_ * 3072 + 128); \
        if (MID) { gn[g_][0] = *(const u32x2*)(Gb + (size_t)row_ * 3072 + 1024); gn[g_][1] = *(const u32x2*)(Gb + (size_t)row_ * 3072 + 1024 + 128); } } while (0)
#define UB(w_, i_) ((float)(((w_) >> (8 * (i_))) & 255u))
#define RB(w_, i_) __builtin_amdgcn_rcpf((float)(((w_) >> (8 * (i_))) & 255u))
#define MRG_BODY(MID) do { gw[0][0] = pr.w0; gw[0][1] = pr.w1; gn[0][0] = pr.n0; gn[0][1] = pr.n1; gw[1][0] = pr.w2; gw[1][1] = pr.w3; gn[1][0] = pr.n2; gn[1][1] = pr.n3; MRG_LOAD(2, MID); MRG_LOAD(3, MID); MRG_LOAD(4, MID); \
        _Pragma("unroll") for (int g = 0; g < 8; ++g) { \
            asm volatile("" ::: "memory"); \
            if (g + 5 < 8) MRG_LOAD(g + 5, MID); \
            const int ai = g >> 2, m = g & 3, row = rowb + ai * 128 + m * 16; \
            _Pragma("unroll") for (int bj = 0; bj < 2; ++bj) { const u32x2 q = gw[g][bj]; \
                f32x4 s0 = (f32x4){UB(q.x, 0), UB(q.x, 1), UB(q.x, 2), UB(q.x, 3)}, s1 = (f32x4){UB(q.y, 0), UB(q.y, 1), UB(q.y, 2), UB(q.y, 3)}; \
                if (MID) { const u32x2 d = gn[g][bj]; \
                    acc[ai][bj][m][0] = acc[ai][bj][m][0] * (s0 * (f32x4){RB(d.x, 0), RB(d.x, 1), RB(d.x, 2), RB(d.x, 3)}); \
                    acc[ai][bj][m][1] = acc[ai][bj][m][1] * (s1 * (f32x4){RB(d.y, 0), RB(d.y, 1), RB(d.y, 2), RB(d.y, 3)}); } \
                else { const float k_ = 1.0f / 255.0f; \
                    *(u32x4*)(MRG + (size_t)row * 1024 + bj * 128) = pack8(acc[ai][bj][m][0] * (s0 * k_), acc[ai][bj][m][1] * (s1 * k_)); } } } } while (0)
        if (which < 2) MRG_BODY(1); else MRG_BODY(0);
#undef MRG_BODY
#undef RB
#undef UB
#undef MRG_LOAD
        return 16;
    }
};

__device__ __forceinline__ void final_norm_rows(const Ctx& c, int m_lo, int m_hi, int wv, int nwv) {
    const unsigned long long* SSQ2 = (const unsigned long long*)(c.ws + WS_SSQ) + 2 * (size_t)MALL;
    const f32x4* gp = (const f32x4*)P_FG(c) + 4 * c.lane; const f32x4 g0 = gp[0], g1 = gp[1], g2 = gp[2], g3 = gp[3];
    for (int m0 = m_lo + wv * 4; m0 < m_hi; m0 += nwv * 4) {
        u32x4 xa[4], xb[4]; float rs[4];
#pragma unroll
        for (int r = 0; r < 4; ++r) { const u32x4* xp = (const u32x4*)((const bf16*)(c.ws + WS_XB) + (size_t)(m0 + r) * D) + 2 * c.lane; xa[r] = xp[0]; xb[r] = xp[1]; rs[r] = row_rstd(SSQ2, m0 + r); }
#pragma unroll
        for (int r = 0; r < 4; ++r) { f32x4* op = (f32x4*)(c.out + (size_t)(m0 + r) * D) + 4 * c.lane; const float k = rs[r];
            op[0] = (f32x4){bflo(xa[r].x), bfhi(xa[r].x), bflo(xa[r].y), bfhi(xa[r].y)} * k * g0; op[1] = (f32x4){bflo(xa[r].z), bfhi(xa[r].z), bflo(xa[r].w), bfhi(xa[r].w)} * k * g1;
            op[2] = (f32x4){bflo(xb[r].x), bfhi(xb[r].x), bflo(xb[r].y), bfhi(xb[r].y)} * k * g2; op[3] = (f32x4){bflo(xb[r].z), bfhi(xb[r].z), bflo(xb[r].w), bfhi(xb[r].w)} * k * g3; }
    }
}

namespace att {
typedef short v4i16_t __attribute__((ext_vector_type(4)));
constexpr int SLOT = 8192, SLOT_V = 4096;
constexpr float THR = 8.0f, NEG_BIG = -1.0e30f, QK_BOUND = 48.0f;
__device__ __forceinline__ int crow(int r, int hi) { return (r & 3) + 8 * (r >> 2) + 4 * hi; }
__device__ __forceinline__ void glds16(const void* gsrc, unsigned lds_dst) { unsigned keep;
    asm volatile("s_mov_b32 %0, m0\n\ts_mov_b32 m0, %2\n\ts_nop 0\n\tglobal_load_lds_dwordx4 %1, off\n\ts_mov_b32 m0, %0" : "=&s"(keep) : "v"(gsrc), "s"(lds_dst) : "memory"); }
__device__ __forceinline__ void dma_slot(LAS unsigned char* slot, const char* kbase, const char* vbase, long stride, int w, int lane) {
    const unsigned sb = (unsigned)(uintptr_t)slot;
    if (w < 4) { const char* s = kbase + (long)(lane & 31) * stride + (2 * w + (lane >> 5)) * 16;
        glds16(s, (unsigned)__builtin_amdgcn_readfirstlane((int)(sb + w * 1024))); }
    else { const int w2 = w - 4; const char* s = vbase + (long)(16 * (w2 & 1) + (lane >> 2)) * stride + (w2 >> 1) * 64 + (lane & 3) * 16;
        glds16(s, (unsigned)__builtin_amdgcn_readfirstlane((int)(sb + SLOT_V + w2 * 1024))); }
}
__device__ __forceinline__ void qk_slot(f32x16& p, LAS const unsigned char* slot, const bf16x8 (&qr)[4], int r32, int hi) {
#pragma unroll
    for (int d0 = 0; d0 < 4; ++d0) { const bf16x8 kf = *(LAS const bf16x8*)(slot + (2 * d0 + hi) * 512 + r32 * 16);
        p = __builtin_amdgcn_mfma_f32_32x32x16_bf16(kf, qr[d0], p, 0, 0, 0); }
}
__device__ __forceinline__ bf16x8 vfrag(LAS const unsigned char* vp) {
    const v4i16_t lo = __builtin_amdgcn_ds_read_tr16_b64_v4i16((LAS v4i16_t*)vp), hi = __builtin_amdgcn_ds_read_tr16_b64_v4i16((LAS v4i16_t*)(vp + 512));
    return (bf16x8){lo[0], lo[1], lo[2], lo[3], hi[0], hi[1], hi[2], hi[3]};
}
__device__ __forceinline__ bf16x8 pack_p(const f32x16& p, int b) {
    u32x4 w; w.x = pg8::cvt_pk_bf16(p[b], p[b + 1]); w.y = pg8::cvt_pk_bf16(p[b + 2], p[b + 3]); w.z = pg8::cvt_pk_bf16(p[b + 4], p[b + 5]); w.w = pg8::cvt_pk_bf16(p[b + 6], p[b + 7]);
    return __builtin_bit_cast(bf16x8, w);
}
__device__ __forceinline__ void pv_slot(f32x16& o0, f32x16& o1, const f32x16& p, LAS const unsigned char* slot, int voff) {
    const bf16x8 pa0 = pack_p(p, 0), pa1 = pack_p(p, 8);
    LAS const unsigned char* vp = slot + SLOT_V + voff;
    o0 = __builtin_amdgcn_mfma_f32_32x32x16_bf16(pa0, vfrag(vp), o0, 0, 0, 0);
    o1 = __builtin_amdgcn_mfma_f32_32x32x16_bf16(pa0, vfrag(vp + 2048), o1, 0, 0, 0);
    o0 = __builtin_amdgcn_mfma_f32_32x32x16_bf16(pa1, vfrag(vp + 1024), o0, 0, 0, 0);
    o1 = __builtin_amdgcn_mfma_f32_32x32x16_bf16(pa1, vfrag(vp + 3072), o1, 0, 0, 0);
}
__device__ __forceinline__ float max_halves(float v) { const auto r = __builtin_amdgcn_permlane32_swap(__float_as_uint(v), __float_as_uint(v), false, false); return fmaxf(__uint_as_float(r[0]), __uint_as_float(r[1])); }
__device__ __forceinline__ float sum_halves(float v) { const auto r = __builtin_amdgcn_permlane32_swap(__float_as_uint(v), __float_as_uint(v), false, false); return __uint_as_float(r[0]) + __uint_as_float(r[1]); }
struct St { float mref, l; f32x16 o0, o1; };
__device__ __forceinline__ void st_init(St& s) { s.mref = NEG_BIG; s.l = 0.f; s.o0 = f32x16{}; s.o1 = f32x16{}; }
__device__ __forceinline__ float max16(const f32x16& p) {
    float a = fmaxf(fmaxf(p[0], p[1]), p[2]), b = fmaxf(fmaxf(p[3], p[4]), p[5]);
    a = fmaxf(fmaxf(a, p[6]), p[7]); b = fmaxf(fmaxf(b, p[8]), p[9]); a = fmaxf(fmaxf(a, p[10]), p[11]); b = fmaxf(fmaxf(b, p[12]), p[13]);
    return fmaxf(fmaxf(a, b), fmaxf(p[14], p[15]));
}
__device__ __forceinline__ void sm_rescale(St& s, float tm, LAS float* wsf, int r32, int hi) {
    tm = max_halves(tm);
    const bool need = tm > s.mref + THR;
    if (__any(need)) {
        const float mn = need ? tm : s.mref, alpha = fexp2(s.mref - mn);
        s.mref = mn; s.l *= alpha;
        if (hi == 0) wsf[r32] = alpha;
        asm volatile("s_waitcnt lgkmcnt(0)" ::: "memory");
#pragma unroll
        for (int r = 0; r < 16; ++r) { const float a = wsf[crow(r, hi)]; s.o0[r] *= a; s.o1[r] *= a; }
    }
}
__device__ __forceinline__ void sm_exp(St& s, f32x16& p) {
    float sum = 0.f;
#pragma unroll
    for (int r = 0; r < 16; ++r) { p[r] = fexp2(p[r] - s.mref); sum += p[r]; }
    s.l += sum;
}
template <class RowFn>
__device__ __forceinline__ float finish(St& s, LAS float* wsf, LAS unsigned char* stg, bf16* zy_col, RowFn row_of, int lane, int r32, int hi, int dry = 0, const u32x4* zpre = nullptr) {
    u32x4 zv[4]; bf16* dstp[4];
#pragma unroll
    for (int i = 0; i < 4; ++i) { const int q = i * 8 + (lane >> 3), ch = lane & 7; dstp[i] = zy_col + (size_t)row_of(q) * 1792 + ch * 8; zv[i] = zpre ? zpre[i] : *(const u32x4*)dstp[i]; }
    float l = sum_halves(s.l);
    if (hi == 0) wsf[32 + r32] = l;
    asm volatile("s_waitcnt lgkmcnt(0)" ::: "memory");
    LAS bf16* st = (LAS bf16*)stg;
#pragma unroll
    for (int r = 0; r < 16; ++r) { const int q = crow(r, hi); const float rl = __builtin_amdgcn_rcpf(wsf[32 + q]);
        st[q * 64 + r32] = (bf16)f2bf(s.o0[r] * rl); st[q * 64 + 32 + r32] = (bf16)f2bf(s.o1[r] * rl); }
    asm volatile("s_waitcnt lgkmcnt(0)" ::: "memory");
#pragma unroll
    for (int i = 0; i < 4; ++i) { const int q = i * 8 + (lane >> 3), ch = lane & 7;
        const u32x4 ov = *(LAS const u32x4*)(stg + q * 128 + ch * 16); const u32x4 z = zv[i]; u32x4 y;
        y.x = pk2(bflo(ov.x) * bflo(z.x), bfhi(ov.x) * bfhi(z.x)); y.y = pk2(bflo(ov.y) * bflo(z.y), bfhi(ov.y) * bfhi(z.y));
        y.z = pk2(bflo(ov.z) * bflo(z.z), bfhi(ov.z) * bfhi(z.z)); y.w = pk2(bflo(ov.w) * bflo(z.w), bfhi(ov.w) * bfhi(z.w));
        if (!dry) *(u32x4*)dstp[i] = y; }
    return s.mref + __log2f(l);
}
constexpr int L_RING = 0, L_CUM = 98304, L_WSF = 106496, L_STG = 110592, L_MSK = 131072, L_Q = 163840 - 320;


constexpr int RD = 4;
#define ATT_DMA_TILE(tt, kb_, vb_, stride_, w_) do { LAS unsigned char* d_ = ring + ((tt) % RD) * 2 * SLOT; const long ro_ = (long)(tt) * 64 * (stride_); \
    dma_slot(d_, (kb_) + ro_, (vb_) + ro_, (stride_), (w_), lane); dma_slot(d_ + SLOT, (kb_) + ro_ + 32 * (stride_), (vb_) + ro_ + 32 * (stride_), (stride_), (w_), lane); } while (0)
#define ATT_WAIT_NEXT(t, NTL_) do { const int last_ = ((t) + RD - 1 < (NTL_) - 1) ? (t) + RD - 1 : (NTL_) - 1; const int fly_ = last_ - ((t) + 1); \
    if (fly_ >= 2) asm volatile("s_waitcnt vmcnt(4)" ::: "memory"); else if (fly_ == 1) asm volatile("s_waitcnt vmcnt(2)" ::: "memory"); else asm volatile("s_waitcnt vmcnt(0)" ::: "memory"); \
    asm volatile("s_waitcnt lgkmcnt(0)" ::: "memory"); __builtin_amdgcn_s_barrier(); } while (0)
__device__ __forceinline__ void unitA(const Ctx& c, int b, int h, int qb) {
    int lane = c.lane; asm volatile("" : "+v"(lane));
    const int r32 = lane & 31, hi = lane >> 5, w = c.wave;
    LAS unsigned char* ring = c.lds + L_RING; LAS float* cumL = (LAS float*)(c.lds + L_CUM); LAS float* wsf = (LAS float*)(c.lds + L_WSF + w * 256);
    const int q0 = qb * 256, qabs = q0 + 32 * w + r32, NTL = 4 * (qb + 1);
    const bf16* QKVA = B_QKVA(c); const long stride = 1536 * 2;
    const char* kb = (const char*)(QKVA + (size_t)(b * S) * 1536 + 512 + h * 64); const char* vb = kb + 1024;
    const float* cum = B_CUM(c) + (size_t)(b * 8 + h) * S;
    for (int s = c.tid; s < q0 + 256; s += NT) cumL[s] = cum[s];
    bf16x8 qr[4];
#pragma unroll
    for (int d0 = 0; d0 < 4; ++d0) qr[d0] = *(const bf16x8*)(QKVA + (size_t)(b * S + qabs) * 1536 + h * 64 + d0 * 16 + hi * 8);
    const float cq = cum[qabs];
    St s; st_init(s);
    const int voff = ((lane >> 4) & 1) * 32 + (lane & 3) * 8 + (4 * hi + ((lane & 15) >> 2)) * 64;
    int T0;
    { const int tl = lane < NTL ? lane : NTL - 1; const int ke = 64 * tl + 63 < q0 ? 64 * tl + 63 : q0;
      const float bnd = cum[q0] - cum[ke];
      const unsigned long long ok = __ballot(bnd >= -(40.0f + 2.0f * QK_BOUND));
      T0 = __builtin_amdgcn_readfirstlane((int)__builtin_ctzll(ok)); }
    asm volatile("s_waitcnt vmcnt(0)" ::: "memory");
#pragma unroll
    for (int tt = 0; tt < RD - 1; ++tt) if (T0 + tt < NTL) ATT_DMA_TILE(T0 + tt, kb, vb, stride, w);
    ATT_WAIT_NEXT(T0 - 1, NTL);
    for (int t = T0; t < NTL; ++t) {
        LAS unsigned char* cur = ring + (t % RD) * 2 * SLOT;
        if (t + RD - 1 < NTL) ATT_DMA_TILE(t + RD - 1, kb, vb, stride, w);
        if (64 * t <= q0 + 32 * w + 31) {
            f32x16 p0, p1;
#pragma unroll
            for (int g = 0; g < 4; ++g) { const f32x4 c0 = *(LAS const f32x4*)(cumL + 64 * t + 8 * g + 4 * hi), c1 = *(LAS const f32x4*)(cumL + 64 * t + 32 + 8 * g + 4 * hi);
                p0[4 * g] = cq - c0.x; p0[4 * g + 1] = cq - c0.y; p0[4 * g + 2] = cq - c0.z; p0[4 * g + 3] = cq - c0.w;
                p1[4 * g] = cq - c1.x; p1[4 * g + 1] = cq - c1.y; p1[4 * g + 2] = cq - c1.z; p1[4 * g + 3] = cq - c1.w; }
            qk_slot(p0, cur, qr, r32, hi); qk_slot(p1, cur + SLOT, qr, r32, hi);
            if (64 * t + 63 > q0 + 32 * w) {
#pragma unroll
                for (int r = 0; r < 16; ++r) { const int k = 64 * t + crow(r, hi); if (k > qabs) p0[r] = -INFINITY; if (k + 32 > qabs) p1[r] = -INFINITY; }
            }
            sm_rescale(s, fmaxf(max16(p0), max16(p1)), wsf, r32, hi);
            sm_exp(s, p0); sm_exp(s, p1);
            pv_slot(s.o0, s.o1, p0, cur, voff); pv_slot(s.o0, s.o1, p1, cur + SLOT, voff);
        }
        ATT_WAIT_NEXT(t, NTL);
    }
    const int rowb = b * S + q0 + 32 * w;
    (void)finish(s, wsf, c.lds + L_STG + w * 4096, B_ZY(c) + h * 64, [rowb](int q) { return rowb + q; }, lane, r32, hi, c.dry);
    __syncthreads();
}

__device__ __forceinline__ void unitB2(const Ctx& c, int b, int jj) {
    int lane = c.lane; asm volatile("" : "+v"(lane));
    const int r32 = lane & 31, hi = lane >> 5, h = c.wave;
    LAS unsigned char* ring = c.lds + L_RING;
    LAS float* wsf0 = (LAS float*)(c.lds + L_WSF + h * 512); LAS float* wsf1 = wsf0 + 64;
    const int t0 = 64 * jj, NTL = jj + 1, qa0 = t0 + r32, qa1 = t0 + 32 + r32;
    const long stride = 128 * 2;
    const char* kb = (const char*)(B_KVB(c) + (size_t)(b * S) * 128); const char* vb = kb + 128;
#define B_DMA_SEQ(i_) do { const int tt_ = NTL - 1 - (i_); LAS unsigned char* d_ = ring + ((i_) % RD) * 2 * SLOT; const long ro_ = (long)tt_ * 64 * stride; \
        dma_slot(d_, kb + ro_, vb + ro_, stride, h, lane); dma_slot(d_ + SLOT, kb + ro_ + 32 * stride, vb + ro_ + 32 * stride, stride, h, lane); } while (0)
#pragma unroll
    for (int ii = 0; ii < RD - 1; ++ii) if (ii < NTL) B_DMA_SEQ(ii);
    bf16x8 qr0[4], qr1[4];
    LAS unsigned* mskL = (LAS unsigned*)(c.lds + L_RING + 81920);
    { const u32x4* mg = (const u32x4*)(B_MASK(c) + (size_t)(b * S + t0) * 64); const u32x4 ma = mg[c.tid], mb = mg[512 + c.tid];
#pragma unroll
      for (int g = 0; g < 2; ++g) { const int qrow = b * S + t0 + 32 * g + r32;
        const f32x4 sq = *(const f32x4*)(B_SSQC(c) + (size_t)qrow * 8); u32x4 v[4];
#pragma unroll
        for (int d0 = 0; d0 < 4; ++d0) v[d0] = *(const u32x4*)(B_QB(c) + (size_t)qrow * 512 + h * 64 + d0 * 16 + hi * 8);
        const float rs = __builtin_amdgcn_rsqf(((sq.x + sq.y) + (sq.z + sq.w)) * (1.0f / 256) + EPS);
#pragma unroll
        for (int d0 = 0; d0 < 4; ++d0) { u32x4 o;
            o.x = pk2(bflo(v[d0].x) * rs, bfhi(v[d0].x) * rs); o.y = pk2(bflo(v[d0].y) * rs, bfhi(v[d0].y) * rs); o.z = pk2(bflo(v[d0].z) * rs, bfhi(v[d0].z) * rs); o.w = pk2(bflo(v[d0].w) * rs, bfhi(v[d0].w) * rs);
            if (g == 0) qr0[d0] = __builtin_bit_cast(bf16x8, o); else qr1[d0] = __builtin_bit_cast(bf16x8, o); } }
      *(LAS u32x4*)(mskL + c.tid * 4) = ma; *(LAS u32x4*)(mskL + 2048 + c.tid * 4) = mb; }
    const float slope2 = exp2f(-(float)(h + 1)) * LOG2E;
    LAS const unsigned* mrow0 = mskL + r32 * 64; LAS const unsigned* mrow1 = mskL + (32 + r32) * 64;
    St s0, s1; st_init(s0); st_init(s1);
    const int voff = ((lane >> 4) & 1) * 32 + (lane & 3) * 8 + (4 * hi + ((lane & 15) >> 2)) * 64;
    asm volatile("s_waitcnt vmcnt(0)" ::: "memory");
    asm volatile("s_waitcnt lgkmcnt(0)" ::: "memory"); __builtin_amdgcn_s_barrier();
    bool done = false;
    for (int i = 0; i < NTL; ++i) {
        const int t = NTL - 1 - i;
        LAS unsigned char* cur = ring + (i % RD) * 2 * SLOT;
        if (i + RD - 1 < NTL) B_DMA_SEQ(i + RD - 1);
        if (!done) {
            const float ub0 = QK_BOUND - slope2 * (float)(qa0 - (64 * t + 63)), ub1 = QK_BOUND - slope2 * (float)(qa1 - (64 * t + 63));
            done = __all(ub0 < s0.mref - (40.0f + THR) && ub1 < s1.mref - (40.0f + THR));
        }
        if (!done) {
        const u32x2 mw0 = *(LAS const u32x2*)(mrow0 + 2 * t), mw1 = *(LAS const u32x2*)(mrow1 + 2 * t);
        const unsigned m00 = mw0.x >> (4 * hi), m01 = mw0.y >> (4 * hi), m10 = mw1.x >> (4 * hi), m11 = mw1.y >> (4 * hi);
        const float base0 = slope2 * (float)(64 * t + 4 * hi - qa0), base1 = slope2 * (float)(64 * t + 4 * hi - qa1);
        f32x16 p00, p01, p10, p11;
#pragma unroll
        for (int r = 0; r < 16; ++r) { const float kk = (float)((r & 3) + 8 * (r >> 2));
            p00[r] = fmaf(slope2, kk, base0); p01[r] = fmaf(slope2, kk + 32.f, base0); p10[r] = fmaf(slope2, kk, base1); p11[r] = fmaf(slope2, kk + 32.f, base1); }
#pragma unroll
        for (int d0 = 0; d0 < 4; ++d0) {
            const bf16x8 k0 = *(LAS const bf16x8*)(cur + (2 * d0 + hi) * 512 + r32 * 16), k1 = *(LAS const bf16x8*)(cur + SLOT + (2 * d0 + hi) * 512 + r32 * 16);
            p00 = __builtin_amdgcn_mfma_f32_32x32x16_bf16(k0, qr0[d0], p00, 0, 0, 0); p10 = __builtin_amdgcn_mfma_f32_32x32x16_bf16(k0, qr1[d0], p10, 0, 0, 0);
            p01 = __builtin_amdgcn_mfma_f32_32x32x16_bf16(k1, qr0[d0], p01, 0, 0, 0); p11 = __builtin_amdgcn_mfma_f32_32x32x16_bf16(k1, qr1[d0], p11, 0, 0, 0); }
#pragma unroll
        for (int r = 0; r < 16; ++r) { const int pos = (r & 3) + 8 * (r >> 2);
#define B_MSK(p_, m_) do { const unsigned t_ = (unsigned)__builtin_amdgcn_sbfe((int)(m_), pos, 1); p_[r] = __uint_as_float((__float_as_uint(p_[r]) & t_) | (0xFF800000u & ~t_)); } while (0)
            B_MSK(p00, m00); B_MSK(p01, m01); B_MSK(p10, m10); B_MSK(p11, m11); }
#undef B_MSK
        sm_rescale(s0, fmaxf(max16(p00), max16(p01)), wsf0, r32, hi); sm_rescale(s1, fmaxf(max16(p10), max16(p11)), wsf1, r32, hi);
        sm_exp(s0, p00); sm_exp(s1, p10); sm_exp(s0, p01); sm_exp(s1, p11);
        {
            const bf16x8 a00 = pack_p(p00, 0), a01 = pack_p(p00, 8), a10 = pack_p(p10, 0), a11 = pack_p(p10, 8);
            LAS const unsigned char* vp = cur + SLOT_V + voff;
            bf16x8 vf = vfrag(vp);        s0.o0 = __builtin_amdgcn_mfma_f32_32x32x16_bf16(a00, vf, s0.o0, 0, 0, 0); s1.o0 = __builtin_amdgcn_mfma_f32_32x32x16_bf16(a10, vf, s1.o0, 0, 0, 0);
            vf = vfrag(vp + 2048);        s0.o1 = __builtin_amdgcn_mfma_f32_32x32x16_bf16(a00, vf, s0.o1, 0, 0, 0); s1.o1 = __builtin_amdgcn_mfma_f32_32x32x16_bf16(a10, vf, s1.o1, 0, 0, 0);
            vf = vfrag(vp + 1024);        s0.o0 = __builtin_amdgcn_mfma_f32_32x32x16_bf16(a01, vf, s0.o0, 0, 0, 0); s1.o0 = __builtin_amdgcn_mfma_f32_32x32x16_bf16(a11, vf, s1.o0, 0, 0, 0);
            vf = vfrag(vp + 3072);        s0.o1 = __builtin_amdgcn_mfma_f32_32x32x16_bf16(a01, vf, s0.o1, 0, 0, 0); s1.o1 = __builtin_amdgcn_mfma_f32_32x32x16_bf16(a11, vf, s1.o1, 0, 0, 0);
            const bf16x8 b00 = pack_p(p01, 0), b01 = pack_p(p01, 8), b10 = pack_p(p11, 0), b11 = pack_p(p11, 8);
            vp += SLOT;
            vf = vfrag(vp);               s0.o0 = __builtin_amdgcn_mfma_f32_32x32x16_bf16(b00, vf, s0.o0, 0, 0, 0); s1.o0 = __builtin_amdgcn_mfma_f32_32x32x16_bf16(b10, vf, s1.o0, 0, 0, 0);
            vf = vfrag(vp + 2048);        s0.o1 = __builtin_amdgcn_mfma_f32_32x32x16_bf16(b00, vf, s0.o1, 0, 0, 0); s1.o1 = __builtin_amdgcn_mfma_f32_32x32x16_bf16(b10, vf, s1.o1, 0, 0, 0);
            vf = vfrag(vp + 1024);        s0.o0 = __builtin_amdgcn_mfma_f32_32x32x16_bf16(b01, vf, s0.o0, 0, 0, 0); s1.o0 = __builtin_amdgcn_mfma_f32_32x32x16_bf16(b11, vf, s1.o0, 0, 0, 0);
            vf = vfrag(vp + 3072);        s0.o1 = __builtin_amdgcn_mfma_f32_32x32x16_bf16(b01, vf, s0.o1, 0, 0, 0); s1.o1 = __builtin_amdgcn_mfma_f32_32x32x16_bf16(b11, vf, s1.o1, 0, 0, 0);
        }
        }
        ATT_WAIT_NEXT(i, NTL);
    }
#undef B_DMA_SEQ
    const int rowb0 = b * S + t0, rowb1 = rowb0 + 32;
    (void)finish(s0, wsf0, c.lds + L_STG + h * 4096, B_ZY(c) + 512 + h * 64, [rowb0](int q) { return rowb0 + q; }, lane, r32, hi, c.dry);
    asm volatile("s_waitcnt lgkmcnt(0)" ::: "memory");
    (void)finish(s1, wsf1, c.lds + L_STG + h * 4096, B_ZY(c) + 512 + h * 64, [rowb1](int q) { return rowb1 + q; }, lane, r32, hi, c.dry);
    __syncthreads();
}

struct CPre { bf16x8 qr[4]; u32x4 zv[4]; };
struct CGeo { int g, L, lgL, lgD, b, r0; float slope2; };
__device__ __forceinline__ CGeo c_geo(int blk, int hd) { CGeo q; q.g = hd >> 2; const int dil = q.g == 0 ? 1 : (q.g == 1 ? 4 : 16); q.L = S / dil; q.lgL = q.g == 0 ? 11 : (q.g == 1 ? 9 : 7); q.lgD = q.g == 0 ? 0 : (q.g == 1 ? 2 : 4);
    q.b = blk >> 3; q.r0 = (blk & 7) * 256; q.slope2 = exp2f(-8.0f * (float)(hd + 1) / 12.0f) * LOG2E * (float)dil; return q; }
__device__ __forceinline__ void unitC_issue(const Ctx& c, int blk, int hd, CPre& P, int lane) {
    const int r32 = lane & 31, hi = lane >> 5, w = c.wave; const CGeo G = c_geo(blk, hd);
    LAS unsigned char* ring = c.lds + L_RING;
    const bf16* QKVC = B_QKVC(c); const long stride = 2304 * 2;
    const char* kb = (const char*)(QKVC + (size_t)(G.b * S) * 2304 + 768 + hd * 64); const char* vb = kb + 1536;
#pragma unroll
    for (int i = 0; i < 12; ++i) { int rr = G.r0 - 128 + 32 * i; if (rr < 0) rr = 0; dma_slot(ring + i * SLOT, kb + (long)rr * stride, vb + (long)rr * stride, stride, w, lane); }
    const int rq = G.r0 + 32 * w + r32;
#pragma unroll
    for (int d0 = 0; d0 < 4; ++d0) P.qr[d0] = *(const bf16x8*)(QKVC + (size_t)(G.b * S + rq) * 2304 + hd * 64 + d0 * 16 + hi * 8);
    const int rbase = G.r0 + 32 * w, bS = G.b * S;
#pragma unroll
    for (int i = 0; i < 4; ++i) { const int rr = rbase + i * 8 + (lane >> 3); const int row = bS + (rr >> G.lgL) + ((rr & (G.L - 1)) << G.lgD);
        P.zv[i] = *(const u32x4*)(B_ZY(c) + 1024 + hd * 64 + (size_t)row * 1792 + (lane & 7) * 8); }
}
template <class Mid>
__device__ __forceinline__ void unitC_run(const Ctx& c, int blk, int hd, CPre& P, int lane, Mid mid) {
    const int r32 = lane & 31, hi = lane >> 5, w = c.wave; const CGeo G = c_geo(blk, hd);
    LAS unsigned char* ring = c.lds + L_RING; LAS float* wsf = (LAS float*)(c.lds + L_WSF + w * 256);
    const int lgL = G.lgL, lgD = G.lgD, L = G.L, r0 = G.r0;
    const int rq = r0 + 32 * w + r32; const float slope2 = G.slope2;
    const int cs = (rq >> lgL) << lgL;
    St s; st_init(s);
    const int voff = ((lane >> 4) & 1) * 32 + (lane & 3) * 8 + (4 * hi + ((lane & 15) >> 2)) * 64;
#pragma unroll 1
    for (int i = 0; i < 5; ++i) {
        LAS unsigned char* cur = ring + (w + i) * SLOT;
        const int rk0 = r0 - 128 + 32 * (w + i) + 4 * hi;
        f32x16 p;
#pragma unroll
        for (int r = 0; r < 16; ++r) p[r] = slope2 * (float)(rk0 + (r & 3) + 8 * (r >> 2) - rq);
        qk_slot(p, cur, P.qr, r32, hi);
#pragma unroll
        for (int r = 0; r < 16; ++r) { const int rk = rk0 + (r & 3) + 8 * (r >> 2); if (rk > rq || rk < rq - 128 || rk < cs) p[r] = -INFINITY; }
        sm_rescale(s, max16(p), wsf, r32, hi);
        sm_exp(s, p);
        pv_slot(s.o0, s.o1, p, cur, voff);
    }
    u32x4 zc[4];
#pragma unroll
    for (int i = 0; i < 4; ++i) zc[i] = P.zv[i];
    mid();
    const int rbase = r0 + 32 * w, bS = G.b * S;
    const float lse = finish(s, wsf, c.lds + L_STG + w * 4096, B_ZY(c) + 1024 + hd * 64,
                             [=](int q) { const int rr = rbase + q; return bS + (rr >> lgL) + ((rr & (L - 1)) << lgD); }, lane, r32, hi, 0, zc);
    if (hi == 0) { const int rr = rbase + r32; B_LSE(c)[(size_t)(bS + (rr >> lgL) + ((rr & (L - 1)) << lgD)) * 12 + hd] = lse; }
}
__device__ __forceinline__ void unitCfix(const Ctx& c, int blk) {
    int lane = c.lane; asm volatile("" : "+v"(lane));
#pragma unroll 1
    for (int st = 0; st < 8; ++st) {
        const int r0 = blk * 256 + c.wave * 32 + st * 4;
        u32x4 v[6]; float l0[6], l1[6], l2[6]; u32x4* pp[6]; int gsel[6];
#pragma unroll
        for (int k = 0; k < 6; ++k) { const int ck = lane + 64 * k, row = r0 + ck / 96, q = ck % 96, hd = q >> 3, j = hd & 3;
            pp[k] = (u32x4*)(B_ZY(c) + (size_t)row * 1792 + 1024) + q; v[k] = *pp[k]; gsel[k] = hd >> 2;
            const float* ls = B_LSE(c) + (size_t)row * 12 + j; l0[k] = ls[0]; l1[k] = ls[4]; l2[k] = ls[8]; }
#pragma unroll
        for (int k = 0; k < 6; ++k) {
            const float lm = fmaxf(l0[k], fmaxf(l1[k], l2[k])), e0 = fexp2(l0[k] - lm), e1 = fexp2(l1[k] - lm), e2 = fexp2(l2[k] - lm);
            const float a = (gsel[k] == 0 ? e0 : (gsel[k] == 1 ? e1 : e2)) * __builtin_amdgcn_rcpf(e0 + e1 + e2);
            u32x4 q = v[k];
            q.x = pk2(bflo(q.x) * a, bfhi(q.x) * a); q.y = pk2(bflo(q.y) * a, bfhi(q.y) * a); q.z = pk2(bflo(q.z) * a, bfhi(q.z) * a); q.w = pk2(bflo(q.w) * a, bfhi(q.w) * a);
            *pp[k] = q; }
    }
}
__device__ __forceinline__ void unitKV(const Ctx& c, int blk) {
    const int r32 = c.lane & 31, hi = c.lane >> 5, row = blk * 256 + c.wave * 32 + r32;
    const bf16* ap = B_CKV(c) + (size_t)row * 128 + hi * 8; const bf16* W = B_WKVT(c);
    bf16x8 a[8];
#pragma unroll
    for (int k = 0; k < 8; ++k) a[k] = *(const bf16x8*)(ap + 16 * k);
    const f32x4 q = *(const f32x4*)(B_SSQC(c) + (size_t)row * 8 + 4); const float rs = 1.0f / sqrtf(((q.x + q.y) + (q.z + q.w)) * (1.0f / 128) + EPS);
#pragma unroll 1
    for (int nt = 0; nt < 4; ++nt) { f32x16 acc = {}; const bf16* bp = W + (size_t)(nt * 32 + r32) * 128 + hi * 8;
        bf16x8 w[8];
#pragma unroll
        for (int k = 0; k < 8; ++k) w[k] = *(const bf16x8*)(bp + 16 * k);
        asm volatile("" : "+v"(w[0]), "+v"(w[1]), "+v"(w[2]), "+v"(w[3]), "+v"(w[4]), "+v"(w[5]), "+v"(w[6]), "+v"(w[7]));
#pragma unroll
        for (int k = 0; k < 8; ++k) acc = __builtin_amdgcn_mfma_f32_32x32x16_bf16(w[k], a[k], acc, 0, 0, 0);
#pragma unroll
        for (int g = 0; g < 4; ++g) st_bf4(B_KVB(c) + (size_t)row * 128 + nt * 32 + 8 * g + 4 * hi, (f32x4){acc[4 * g], acc[4 * g + 1], acc[4 * g + 2], acc[4 * g + 3]} * rs); }
}
__device__ __forceinline__ void unitCum(const Ctx& c, int b) {
    const int h = c.wave, lane = c.lane; const float bf = P_BF(c)[c.layer * 8 + h];
    const float* wf = B_WF(c) + (size_t)(b * S + 32 * lane) * 16 + 8 + h; float v[32]; float run = 0.f;
#pragma unroll
    for (int i = 0; i < 32; ++i) { run += logsigmoidf_(wf[i * 16] + bf) * LOG2E; v[i] = run; }
    float incl = run;
#pragma unroll
    for (int o = 1; o < 64; o <<= 1) { const float t = shup(incl, o, lane); if (lane >= o) incl += t; }
    const float excl = incl - run; float* dst = B_CUM(c) + (size_t)(b * 8 + h) * S + 32 * lane;
#pragma unroll
    for (int i = 0; i < 32; i += 4) *(f32x4*)(dst + i) = (f32x4){v[i] + excl, v[i + 1] + excl, v[i + 2] + excl, v[i + 3] + excl};
}

__device__ __forceinline__ unsigned sortable(float sc) { sc += 0.0f; const unsigned bits = __builtin_bit_cast(unsigned, sc); return (bits & 0x80000000u) ? ~bits : (bits | 0x80000000u); }
__device__ __forceinline__ unsigned wave_sum_u(unsigned v) {
    v += (unsigned)__builtin_amdgcn_update_dpp(0, (int)v, 0x111, 0xf, 0xf, true);
    v += (unsigned)__builtin_amdgcn_update_dpp(0, (int)v, 0x112, 0xf, 0xf, true);
    v += (unsigned)__builtin_amdgcn_update_dpp(0, (int)v, 0x114, 0xf, 0xf, true);
    v += (unsigned)__builtin_amdgcn_update_dpp(0, (int)v, 0x118, 0xf, 0xf, true);
    return (unsigned)__builtin_amdgcn_readlane((int)v, 15) + (unsigned)__builtin_amdgcn_readlane((int)v, 31) + (unsigned)__builtin_amdgcn_readlane((int)v, 47) + (unsigned)__builtin_amdgcn_readlane((int)v, 63);
}
__device__ __forceinline__ unsigned half_sum16(unsigned v, int hi) {
    v += (unsigned)__builtin_amdgcn_update_dpp(0, (int)v, 0x111, 0xf, 0xf, true);
    v += (unsigned)__builtin_amdgcn_update_dpp(0, (int)v, 0x112, 0xf, 0xf, true);
    v += (unsigned)__builtin_amdgcn_update_dpp(0, (int)v, 0x114, 0xf, 0xf, true);
    v += (unsigned)__builtin_amdgcn_update_dpp(0, (int)v, 0x118, 0xf, 0xf, true);
    const unsigned lo = (unsigned)__builtin_amdgcn_readlane((int)v, 15) + (unsigned)__builtin_amdgcn_readlane((int)v, 31);
    const unsigned hs = (unsigned)__builtin_amdgcn_readlane((int)v, 47) + (unsigned)__builtin_amdgcn_readlane((int)v, 63);
    return hi ? hs : lo;
}
__device__ __forceinline__ void sel_issue(const Ctx& c, int b, int j, int lane) {
    const int r32 = lane & 31, hi = lane >> 5, w = c.wave, ntile = j + 1;
    LAS unsigned char* kl = c.lds; const bf16* KI = B_KI(c) + (size_t)(b * S) * 32;
    for (int k = w; k < ntile; k += 8) {
        const char* sp = (const char*)(KI + (size_t)(32 * k + r32) * 32 + 8 * hi);
        glds16(sp, (unsigned)__builtin_amdgcn_readfirstlane((int)((unsigned)(uintptr_t)kl + k * 2048)));
        glds16(sp + 32, (unsigned)__builtin_amdgcn_readfirstlane((int)((unsigned)(uintptr_t)kl + k * 2048 + 1024)));
    }
}
template <class Mid>
__device__ __forceinline__ void unitSel(const Ctx& c, int b, int j, bool pre, Mid mid) {
    int lane = c.lane; asm volatile("" : "+v"(lane));
    const int r32 = lane & 31, hi = lane >> 5, w = c.wave, ntile = j + 1;
    LAS unsigned char* kl = c.lds;
    if (!pre) sel_issue(c, b, j, lane);
    const int tq = 32 * j + 4 * w;
    bf16x8 aop[2];
    { const int a = r32 & 3, hb = (r32 >> 2) & 1, cc = r32 >> 3, h = a + 4 * (cc & 1), qi = hb + 2 * (cc >> 1);
      const bf16* qp = B_QI(c) + (size_t)(b * S + tq + qi) * 256 + h * 32 + 8 * hi;
      aop[0] = *(const bf16x8*)qp; aop[1] = *(const bf16x8*)(qp + 16); }
    float wA[8], wB[8];
    { const f32x4* pa = (const f32x4*)(B_WF(c) + (size_t)(b * S + tq + hi) * 16); const f32x4* pb = (const f32x4*)(B_WF(c) + (size_t)(b * S + tq + hi + 2) * 16);
      const f32x4 a0 = pa[0], a1 = pa[1], b0 = pb[0], b1 = pb[1];
      wA[0] = a0.x; wA[1] = a0.y; wA[2] = a0.z; wA[3] = a0.w; wA[4] = a1.x; wA[5] = a1.y; wA[6] = a1.z; wA[7] = a1.w;
      wB[0] = b0.x; wB[1] = b0.y; wB[2] = b0.z; wB[3] = b0.w; wB[4] = b1.x; wB[5] = b1.y; wB[6] = b1.z; wB[7] = b1.w; }
    asm volatile("s_waitcnt vmcnt(0)" ::: "memory"); __syncthreads();
    unsigned uA[64], uB[64];
    const int tA = tq + hi, tB = tq + hi + 2;
#pragma unroll
    for (int k = 0; k < 64; ++k) {
        uA[k] = 0u; uB[k] = 0u;
        if (k < ntile) {
            const bf16x8 b0 = *(LAS const bf16x8*)(kl + k * 2048 + hi * 512 + r32 * 16), b1 = *(LAS const bf16x8*)(kl + k * 2048 + 1024 + hi * 512 + r32 * 16);
            f32x16 d = {};
            d = __builtin_amdgcn_mfma_f32_32x32x16_bf16(aop[0], b0, d, 0, 0, 0);
            d = __builtin_amdgcn_mfma_f32_32x32x16_bf16(aop[1], b1, d, 0, 0, 0);
            float sA = 0.f, sB = 0.f;
#pragma unroll
            for (int r = 0; r < 8; ++r) { sA = fmaf(wA[r], fmaxf(d[r], 0.f), sA); sB = fmaf(wB[r], fmaxf(d[8 + r], 0.f), sB); }
            const int key = 32 * k + r32;
            uA[k] = key <= tA ? sortable(sA) : 0u; uB[k] = key <= tB ? sortable(sB) : 0u;
        }
        if ((k & 1) == 1) __builtin_amdgcn_sched_barrier(0);
    }
    mid();
    unsigned thrA = 0u, thrB = 0u; bool doneA = false, doneB = false;
    if (j < 8) { thrA = thrB = 1u; doneA = doneB = true; }
    for (int bit = 31; bit >= 0 && !__all(doneA && doneB); --bit) {
        const unsigned cA = thrA | (1u << bit), cB = thrB | (1u << bit);
        unsigned cnA0 = 0u, cnA1 = 0u, cnB0 = 0u, cnB1 = 0u;
#pragma unroll
        for (int k0 = 0; k0 < 64; k0 += 16) if (k0 < ntile) {
#pragma unroll
            for (int k = k0; k < k0 + 16; k += 2) {
                asm("v_cmp_ge_u32 vcc, %1, %2\n\tv_addc_co_u32 %0, vcc, 0, %0, vcc" : "+v"(cnA0) : "v"(uA[k]), "v"(cA) : "vcc");
                asm("v_cmp_ge_u32 vcc, %1, %2\n\tv_addc_co_u32 %0, vcc, 0, %0, vcc" : "+v"(cnB0) : "v"(uB[k]), "v"(cB) : "vcc");
                asm("v_cmp_ge_u32 vcc, %1, %2\n\tv_addc_co_u32 %0, vcc, 0, %0, vcc" : "+v"(cnA1) : "v"(uA[k + 1]), "v"(cA) : "vcc");
                asm("v_cmp_ge_u32 vcc, %1, %2\n\tv_addc_co_u32 %0, vcc, 0, %0, vcc" : "+v"(cnB1) : "v"(uB[k + 1]), "v"(cB) : "vcc");
            }
        }
        unsigned cnt = (cnA0 + cnA1) | ((cnB0 + cnB1) << 16);
        cnt = half_sum16(cnt, hi);
        const unsigned nA = cnt & 0xffffu, nB = cnt >> 16;
        if (!doneA && nA >= 256u) { thrA = cA; doneA = (nA == 256u); }
        if (!doneB && nB >= 256u) { thrB = cB; doneB = (nB == 256u); }
    }
    LAS unsigned* msk = (LAS unsigned*)(c.lds + L_MSK + w * 2048);
    *(LAS u32x4*)(msk + lane * 8) = (u32x4){0u, 0u, 0u, 0u}; *(LAS u32x4*)(msk + lane * 8 + 4) = (u32x4){0u, 0u, 0u, 0u};
    asm volatile("s_waitcnt lgkmcnt(0)" ::: "memory");
#pragma unroll
    for (int k0 = 0; k0 < 64; k0 += 16) if (k0 < ntile) {
#pragma unroll
        for (int k = k0; k < k0 + 16; ++k) {
            const unsigned long long ga = __ballot(uA[k] >= thrA), gb = __ballot(uB[k] >= thrB), ta = __ballot(uA[k] > thrA), tb = __ballot(uB[k] > thrB);
            if (lane == 0) { *(LAS u32x4*)(msk + k * 8) = (u32x4){(unsigned)ga, (unsigned)(ga >> 32), (unsigned)gb, (unsigned)(gb >> 32)};
                             *(LAS u32x4*)(msk + k * 8 + 4) = (u32x4){(unsigned)ta, (unsigned)(ta >> 32), (unsigned)tb, (unsigned)(tb >> 32)}; }
            if ((k & 3) == 3) __builtin_amdgcn_sched_barrier(0);
        }
    }
    asm volatile("s_waitcnt lgkmcnt(0)" ::: "memory");
    const u32x4 mm = *(LAS const u32x4*)(msk + lane * 8), gg = *(LAS const u32x4*)(msk + lane * 8 + 4);
    const unsigned M0 = mm.x, M1 = mm.y, M2 = mm.z, M3 = mm.w, G0 = gg.x, G1 = gg.y, G2 = gg.z, G3 = gg.w;
    unsigned* mbase = B_MASK(c) + (size_t)(b * S + tq) * 64 + lane;
#define SEL_FIX_STORE(M, G, qi) do { \
        unsigned m_ = M; const int nge = (int)wave_sum_u((unsigned)__popc(M)); \
        if (j >= 8 && nge > 256) { const unsigned eq = M & ~G; const int pc = __popc(eq); const int ngt = (int)wave_sum_u((unsigned)__popc(G)); \
            int incl = pc; _Pragma("unroll") for (int o = 1; o < 64; o <<= 1) { const int t_ = shupi(incl, o, lane); if (lane >= o) incl += t_; } \
            int keep = 256 - ngt - (incl - pc); keep = keep < 0 ? 0 : (keep > pc ? pc : keep); \
            unsigned kept = eq; while (__popc(kept) > keep) kept &= ~(0x80000000u >> __clz((int)kept)); \
            m_ = G | kept; } \
        mbase[(qi) * 64] = m_; } while (0)
    SEL_FIX_STORE(M0, G0, 0); SEL_FIX_STORE(M1, G1, 1); SEL_FIX_STORE(M2, G2, 2); SEL_FIX_STORE(M3, G3, 3);
#undef SEL_FIX_STORE
    __syncthreads();
}
__device__ __forceinline__ void unitXQ(const Ctx& c, int grow0) {
    const unsigned long long* SSQ1 = (const unsigned long long*)(c.ws + WS_SSQ) + MALL;
#pragma unroll 1
    for (int r0 = 0; r0 < 32; r0 += 4) {
        u32x4 a[4], b[4]; unsigned long long q[4];
#pragma unroll
        for (int r = 0; r < 4; ++r) { const int row = grow0 + c.wave * 32 + r0 + r;
            const u32x4* xp = (const u32x4*)((const bf16*)(c.ws + WS_XB) + (size_t)row * D) + 2 * c.lane; a[r] = xp[0]; b[r] = xp[1]; q[r] = SSQ1[row]; }
        asm volatile("" : "+v"(a[0]), "+v"(a[1]), "+v"(a[2]), "+v"(a[3]), "+v"(b[0]), "+v"(b[1]), "+v"(b[2]), "+v"(b[3]), "+v"(q[0]), "+v"(q[1]), "+v"(q[2]), "+v"(q[3]));
#pragma unroll
        for (int r = 0; r < 4; ++r) { const int row = grow0 + c.wave * 32 + r0 + r;
            const float qs = __builtin_amdgcn_rsqf((float)q[r] * (1.0f / SSQ_SCALE) * (1.0f / D) + EPS) * XQ_SCALE; u32x4 o;
            o.x = pk4q(bflo(a[r].x) * qs, bfhi(a[r].x) * qs, bflo(a[r].y) * qs, bfhi(a[r].y) * qs); o.y = pk4q(bflo(a[r].z) * qs, bfhi(a[r].z) * qs, bflo(a[r].w) * qs, bfhi(a[r].w) * qs);
            o.z = pk4q(bflo(b[r].x) * qs, bfhi(b[r].x) * qs, bflo(b[r].y) * qs, bfhi(b[r].y) * qs); o.w = pk4q(bflo(b[r].z) * qs, bfhi(b[r].z) * qs, bflo(b[r].w) * qs, bfhi(b[r].w) * qs);
            *((u32x4*)(c.ws + WS_XQ + (size_t)row * 1024) + c.lane) = o; }
    }
}
#define RUN_QUEUE(NU, ...) do { LAS int* qw_ = (LAS int*)(c.lds + L_Q); int u = c.bid; \
    while (u < (NU)) { unsigned nx_ = 0u; if (c.tid == 0) nx_ = __hip_atomic_fetch_add(ctr, 1u, __ATOMIC_RELAXED, __HIP_MEMORY_SCOPE_AGENT) + (unsigned)c.G; \
        __VA_ARGS__; \
        if (c.tid == 0) *qw_ = (int)nx_; __syncthreads(); u = *qw_; __syncthreads(); } } while (0)
__device__ __forceinline__ void interval1(const Ctx& c, unsigned* ctr, int lc) {
    constexpr int NC = 12 * (TC / 256), NKV = TC / 256, NCU = CB, NS = 64 * CB;
    const int NXQ = (lc >= 1 && lc <= NCH) ? TC / 256 : 0;
    const int NFN = (lc == 2 * NCH - 1) ? (MALL - TC) / 256 : 0;
    const int N0 = NCU + NKV + NXQ + NFN + NS, NALL = N0 + NC;
    LAS int* qw = (LAS int*)(c.lds + L_Q); int u = c.bid; bool selpre = false;
    while (u < N0) { unsigned nx = 0u; if (c.tid == 0) nx = __hip_atomic_fetch_add(ctr, 1u, __ATOMIC_RELAXED, __HIP_MEMORY_SCOPE_AGENT) + (unsigned)c.G;
        if (u < NCU) unitCum(c, u); else if (u < NCU + NKV) unitKV(c, u - NCU);
        else if (u < NCU + NKV + NXQ) unitXQ(c, (lc - 1) * TC + (u - NCU - NKV) * 256);
        else if (u < NCU + NKV + NXQ + NFN) { const int g0_ = (u - NCU - NKV - NXQ) * 256; final_norm_rows(c, g0_, g0_ + 256, c.wave, NWAVES); }
        else { const int SEL0 = NCU + NKV + NXQ + NFN, r2 = u - SEL0; int un = 0;
            unitSel(c, r2 % CB, 63 - r2 / CB, selpre, [&]() { if (c.tid == 0) *qw = (int)nx; __syncthreads(); un = *qw; selpre = false;
                if (un >= SEL0 && un < N0) { const int rn = un - SEL0; sel_issue(c, rn % CB, 63 - rn / CB, c.lane); selpre = true; } });
            u = un; continue; }
        if (c.tid == 0) *qw = (int)nx; __syncthreads(); u = *qw; __syncthreads(); }
    int lane = c.lane; asm volatile("" : "+v"(lane));
    CPre PA, PB; bool have = false;
#define C_STEP(CUR, NXT) do { unsigned nx = 0u; if (c.tid == 0) nx = __hip_atomic_fetch_add(ctr, 1u, __ATOMIC_RELAXED, __HIP_MEMORY_SCOPE_AGENT) + (unsigned)c.G; \
        const int v_ = u - N0; if (!have) unitC_issue(c, v_ / 12, v_ % 12, CUR, lane); \
        __builtin_amdgcn_s_waitcnt(0x0F70); __syncthreads();              \
        int un_ = 0; \
        unitC_run(c, v_ / 12, v_ % 12, CUR, lane, [&]() { if (c.tid == 0) *qw = (int)nx; __syncthreads(); un_ = *qw; \
            if (un_ < NALL) { const int vn_ = un_ - N0; unitC_issue(c, vn_ / 12, vn_ % 12, NXT, lane); have = true; } else have = false; }); \
        u = un_; } while (0)
    while (u < NALL) { C_STEP(PA, PB); if (u >= NALL) break; C_STEP(PB, PA); }
#undef C_STEP
    __syncthreads();
}
__device__ __forceinline__ void interval2(const Ctx& c, unsigned* ctr) {
    constexpr int PER = 4 * CB + 8 * CB, NAB = 8 * PER, NF = TC / 256;
    RUN_QUEUE(NAB + NF, {
        if (u >= NF) { const int ua = u - NF, grp = ua / PER, r = ua % PER, qb = 7 - grp;
            if (r < 8 * CB) { unitA(c, r >> 3, r & 7, qb); }
            else { const int r2 = r - 8 * CB, jj = 4 * qb + 3 - r2 / CB; unitB2(c, r2 % CB, jj); } }
        else unitCfix(c, u); });
}
#undef RUN_QUEUE
}


__device__ __forceinline__ Ctx fresh(const Ctx& c0) {
    Ctx c = c0;
    int wv = c0.wave; asm volatile("" : "+s"(wv)); const int tid = wv * 64 + lane_now();
    unsigned long long ws = (unsigned long long)c0.ws, out = (unsigned long long)c0.out, lds = (unsigned long long)(unsigned)(uintptr_t)c0.lds;
    asm volatile("" : "+s"(ws)); asm volatile("" : "+s"(out));
    int G = c0.G, bid = c0.bid, layer = c0.layer, row0 = c0.row0;
    asm volatile("" : "+s"(G)); asm volatile("" : "+s"(bid)); asm volatile("" : "+s"(layer)); asm volatile("" : "+s"(row0));
    c.tid = tid; c.lane = tid & 63; c.wave = wv;
    c.ws = (unsigned char*)(GAS unsigned char*)ws; c.out = (float*)(GAS float*)out; c.G = G; c.bid = bid; c.layer = layer; c.row0 = row0;
    c.gw = bid * NWAVES + c.wave; c.NGW = G * NWAVES;
    (void)lds;
    return c;
}

constexpr int STEPS_PER = 8, N_STEPS = 1 + 2 * NCH * STEPS_PER + 1;
template <int PH>
__global__ void __launch_bounds__(NT, 2) mk(Args args) {
    extern __shared__ __attribute__((aligned(16))) unsigned char lds_raw[];
    Ctx c;
    c.lds = (LAS unsigned char*)lds_raw;
    c.tid = threadIdx.x; c.lane = c.tid & 63; c.wave = __builtin_amdgcn_readfirstlane(c.tid >> 6);
    c.G = gridDim.x; c.bid = blockIdx.x; c.gw = c.bid * NWAVES + c.wave; c.NGW = c.G * NWAVES;
    c.ws = args.ws; c.out = args.out; c.in = args.in; c.dry = 0;
    volatile LAS unsigned* MISC = (volatile LAS unsigned*)(c.lds + MISC_OFF);
    if (c.tid < 32) MISC[c.tid] = 0u;
    __syncthreads();
    const int lo = PH < 0 ? args.lo : 0, hi = PH < 0 ? args.hi : 0;
    XcdBarrier bar; bar.bar = (unsigned*)(c.ws + WS_CTL) + CW_BAR; bar.x = 0; bar.st = nullptr;
    if constexpr (PH < 0) bar = xcd_barrier_post((unsigned*)(c.ws + WS_CTL) + CW_BAR, MISC + 8);
#define IN(k) (lo <= (k) && (k) < hi)
#define SEAM(k) do { if constexpr (PH < 0) { if (IN(k) && IN((k) + 1)) xcd_barrier(bar, c.wave); } } while (0)
#define ON(t, k) ((PH < 0 && IN(k)) || PH == (t))
    ctx_set(c, 0, 0);
    if constexpr (PH < 0 || PH == 0) if (ON(0, 0)) { { Ctx f = fresh(c); p0_prologue(f); } if constexpr (PH < 0) { xcd_barrier(bar, c.wave); Ctx f = fresh(c); p0_prologue_b(f); } SEAM(0); }
    const int lc0 = PH < 0 ? 0 : args.lo, lc1 = PH < 0 ? 2 * NCH : args.lo + 1;
    for (int lc = lc0; lc < lc1; ++lc) {
        const int base = 1 + lc * STEPS_PER;
        if (PH < 0 && (hi <= base || lo >= base + STEPS_PER)) continue;
        ctx_set(c, lc / NCH, lc % NCH);
        if constexpr (PH < 0 || PH == 1) if (ON(1, base + 0)) {
            { Ctx f = fresh(c);
              SubSched Sd{(const char*)(f.ws + WS_XQ + (size_t)f.row0 * 1024), (const char*)(f.ws + WS_W1Q + (size_t)f.layer * N1 * 1024), 512, 512, 8, TC / 256, N1 / 256 - 2, f.G, f.bid, 18, 2};
              EpiP1<true> E{f.ws, f.row0, f.layer, f.lds};
              { const u32x4* src = (const u32x4*)((const unsigned short*)((const unsigned*)(f.ws + WS_CTL) + CW_CS16) + (size_t)f.layer * N1);
                for (int i = f.tid; i < N1 / 8; i += NT) *(LAS u32x4*)(f.lds + L_CS16 + i * 16) = src[i];
                __syncthreads(); }
              pg8::gemm_phase<EpiP1<true>, SubSched, true, true>(f.lds, Sd, E, f.tid); }
            { Ctx f = fresh(c);
              SubSched Sd{(const char*)(B_XB(f) + (size_t)f.row0 * D), (const char*)B_W1T(f), 1024, 1024, 16, TC / 256, 2, f.G, f.bid, 0, 18};
              EpiP1<false> E{f.ws, f.row0, f.layer, f.lds};
              pg8::gemm_phase<EpiP1<false>, SubSched>(f.lds, Sd, E, f.tid); }
            SEAM(base + 0); }
        if constexpr (PH < 0 || PH == 2) if (ON(2, base + 1)) { { Ctx f = fresh(c); att::interval1(f, (unsigned*)(f.ws + WS_CTL) + CW_Q + (lc * 4 + 0) * 64, lc); } SEAM(base + 1); }
        if constexpr (PH < 0 || PH == 4) if (ON(4, base + 3)) { { Ctx f = fresh(c); att::interval2(f, (unsigned*)(f.ws + WS_CTL) + CW_Q + (lc * 4 + 1) * 64); } SEAM(base + 3); }
        if constexpr (PH < 0 || PH == 6) if (ON(6, base + 5)) {
            { Ctx f = fresh(c); MrgSched Sd{f.ws, f.layer, TC / 256, 4, f.G, f.bid}; EpiMrg E{f.ws};
              pg8::gemm_phase<EpiMrg, MrgSched>(f.lds, Sd, E, f.tid); }
            SEAM(base + 5); }
        if constexpr (PH < 0 || PH == 7) if (ON(7, base + 6)) {
            { Ctx f = fresh(c); UniSched Sd{(const char*)B_MRG(f), (const char*)B_WOT(f), 1024, 1024, 16, TC / 256, 4, f.G, f.bid};
              EpiOut E{f.ws, f.row0, f.layer};
              pg8::gemm_phase<EpiOut, UniSched>(f.lds, Sd, E, f.tid); }
            if (lc == 2 * NCH - 1) SEAM(base + 6); }
    }
    if constexpr (PH < 0 || PH == 9) if (ON(9, N_STEPS - 1)) { Ctx f = fresh(c); final_norm_rows(f, MALL - TC, MALL, f.gw, f.NGW); }
#undef IN
#undef SEAM
#undef ON
}

template <int PH> static void launch_ph(int grid, Args a, hipStream_t stream) {
    static bool attr = false;
    if (!attr) { (void)hipFuncSetAttribute((const void*)mk<PH>, hipFuncAttributeMaxDynamicSharedMemorySize, LDS_BYTES); attr = true; }
    hipLaunchKernelGGL(mk<PH>, dim3(grid), dim3(NT), LDS_BYTES, stream, a);
}
extern "C" void kernel_launch(void* const* d_in, const int* in_sizes, int n_in, void* d_out, int out_size, void* d_ws, size_t ws_size, hipStream_t stream) {
    static int grid = 0;
    if (grid == 0) {
        if (n_in != 14 || out_size != MALL * D || ws_size < WS_END) { fprintf(stderr, "kernel_launch: unexpected shapes (n_in %d out %d ws %zu need %zu)\n", n_in, out_size, ws_size, (size_t)WS_END); grid = -1; return; }
        int dev = 0, cus = 0;
        if (hipGetDevice(&dev) != hipSuccess || hipDeviceGetAttribute(&cus, hipDeviceAttributeMultiprocessorCount, dev) != hipSuccess) { grid = -1; return; }
        (void)hipGetLastError();
        int nb = 0;
        (void)hipFuncSetAttribute((const void*)mk<-1>, hipFuncAttributeMaxDynamicSharedMemorySize, LDS_BYTES);
        if (hipOccupancyMaxActiveBlocksPerMultiprocessor(&nb, (const void*)mk<-1>, NT, (size_t)LDS_BYTES) != hipSuccess || nb < 1) { (void)hipGetLastError(); fprintf(stderr, "kernel_launch: occupancy query says %d blocks per CU\n", nb); grid = -1; return; }
        grid = cus;
    }
    if (grid < 0) return;
    (void)hipMemsetAsync((char*)d_ws + WS_CTL, 0, CTL_ZERO_BYTES, stream);
    Args a{};
    for (int i = 0; i < 14; ++i) a.in[i] = (const float*)d_in[i];
    a.out = (float*)d_out; a.ws = (unsigned char*)d_ws;
    a.lo = 0; a.hi = N_STEPS;
    launch_ph<-1>(grid, a, stream);
}
```

```cpp
#include <hip/hip_runtime.h>
#include <cstdio>
#include <cstdint>

#define GAS __attribute__((address_space(1)))
#define LAS __attribute__((address_space(3)))
typedef unsigned short bf16;
typedef short bf16x8 __attribute__((ext_vector_type(8)));
typedef float f32x4 __attribute__((ext_vector_type(4)));
typedef float f32x2v __attribute__((ext_vector_type(2)));
typedef float f32x16 __attribute__((ext_vector_type(16)));
typedef unsigned u32x4 __attribute__((ext_vector_type(4)));
typedef unsigned u32x2 __attribute__((ext_vector_type(2)));
typedef int i32x4 __attribute__((ext_vector_type(4)));

constexpr int S = 2048, NBATCH = 32, D = 1024, MALL = NBATCH * S, DIN = 9136;
constexpr int CB = 16, NCH = NBATCH / CB, TC = CB * S;
constexpr int N1 = 9984;
constexpr float EPS = 1e-6f, LOG2E = 1.4426950408889634f, LN2 = 0.6931471805599453f;
constexpr float XCLIP = 5.0f, XQ_SCALE = 127.0f / XCLIP;
constexpr float SSQ_SCALE = 1048576.0f;
constexpr float QS = 0.125f * LOG2E;
constexpr int C_QA = 0, C_KA = 512, C_VA = 1024, C_QC = 1536, C_KC = 2304, C_VC = 3072, C_CQ = 3840, C_QB = 4096, C_QI = 4608,
              C_CKV = 4864, C_KI = 4992, C_WI = 5024, C_FA = 5032, C_PAD = 5040, C_Z = 5120, C_G = 6912;
constexpr int S_QA = 0, S_KA = 512, S_VA = 1024, S_FA = 1536, S_ZA = 1544, S_CQ = 2056, S_CKV = 2312, S_KI = 2440, S_WI = 2472, S_ZB = 2480,
              S_QC = 2992, S_KC = 3760, S_VC = 4528, S_ZC = 5296, S_GA = 6064, S_GB = 7088, S_GC = 8112;

__host__ __device__ constexpr int src_col(int n) {
    return n < 1536 ? n
         : n < C_KC ? S_QC + (n - C_QC) : n < C_VC ? S_KC + (n - C_KC) : n < C_CQ ? S_VC + (n - C_VC)
         : n < C_QB ? S_CQ + (n - C_CQ) : n < C_CKV ? -2
         : n < C_KI ? S_CKV + (n - C_CKV) : n < C_WI ? S_KI + (n - C_KI) : n < C_FA ? S_WI + (n - C_WI) : n < C_PAD ? S_FA + (n - C_FA)
         : n < C_Z ? -1
         : n < C_Z + 512 ? S_ZA + (n - C_Z) : n < C_Z + 1024 ? S_ZB + (n - C_Z - 512) : n < C_G ? S_ZC + (n - C_Z - 1024)
         : n < C_G + 1024 ? S_GA + (n - C_G) : n < C_G + 2048 ? S_GB + (n - C_G - 1024) : S_GC + (n - C_G - 2048);
}

constexpr size_t MiB = 1u << 20;
constexpr size_t WS_CTL = 0, CTL_ZERO_BYTES = 1 * MiB;
constexpr size_t WS_W1T = 1 * MiB;
constexpr size_t WS_WAT = 40 * MiB, WS_WBT = 42 * MiB, WS_WCT = 44 * MiB, WS_WOT = 47 * MiB, WS_WKVT = 51 * MiB;
constexpr size_t WS_SSQ = 52 * MiB;
constexpr size_t WS_PAD16 = 54 * MiB;
constexpr size_t WS_XB = 56 * MiB;
constexpr size_t WS_CH = 184 * MiB;
constexpr size_t O_QKVA = 0, O_QKVC = O_QKVA + (size_t)TC * 3072, O_QB = O_QKVC + (size_t)TC * 4608, O_QI = O_QB + (size_t)TC * 1024,
                 O_CKV = O_QI + (size_t)TC * 512, O_KI = O_CKV + (size_t)TC * 256, O_WF = O_KI + (size_t)TC * 64, O_SSQC = O_WF + (size_t)TC * 64,
                 O_KVB = O_SSQC + (size_t)TC * 32, O_CUM = O_KVB + (size_t)TC * 256, O_ZY = O_CUM + (size_t)TC * 32, O_G = O_ZY + (size_t)TC * 3584,
                 O_MASK = O_G + (size_t)TC * 3072, O_LSE = O_MASK + (size_t)TC * 256, O_MRG = O_LSE + (size_t)TC * 64, O_CQT = O_MRG + (size_t)TC * 2048,
                 O_END = O_CQT;
constexpr size_t WS_XQ = ((WS_CH + O_END + MiB - 1) / MiB) * MiB;
constexpr size_t WS_W1Q = WS_XQ + (size_t)MALL * 1024;
constexpr size_t WS_END = WS_W1Q + (size_t)2 * N1 * 1024;
static_assert(WS_W1T + (size_t)2 * N1 * 1024 * 2 <= WS_WAT, "w1t");

constexpr int CW_TMO = 0, CW_BAR = 4096, CW_Q = 8192, CW_CMAX = 16384, CW_CS16 = 65536;
constexpr int L_CS16 = 131072;
constexpr int LDS_BYTES = 163840, MISC_OFF = 163840 - 256;
constexpr int NWAVES = 8, NT = 512;


__device__ __forceinline__ unsigned f2bf(float f) { unsigned u = __builtin_bit_cast(unsigned, f); return (u + 0x7fffu + ((u >> 16) & 1u)) >> 16; }
__device__ __forceinline__ unsigned pk2(float lo, float hi) { return f2bf(lo) | (f2bf(hi) << 16); }
__device__ __forceinline__ float bf2f(unsigned short b) { return __builtin_bit_cast(float, (unsigned)b << 16); }
__device__ __forceinline__ float bflo(unsigned w) { return __builtin_bit_cast(float, w << 16); }
__device__ __forceinline__ float bfhi(unsigned w) { return __builtin_bit_cast(float, w & 0xffff0000u); }
__device__ __forceinline__ float fexp2(float x) { return __builtin_amdgcn_exp2f(x); }
__device__ __forceinline__ float sigmoidf_(float x) { return __builtin_amdgcn_rcpf(1.f + __builtin_amdgcn_exp2f(-LOG2E * x)); }
__device__ __forceinline__ float siluf_(float x) { return x * __builtin_amdgcn_rcpf(1.f + __builtin_amdgcn_exp2f(-LOG2E * x)); }
__device__ __forceinline__ float logsigmoidf_(float x) { return fminf(x, 0.f) - log1pf(__expf(-fabsf(x))); }
__device__ __forceinline__ float shx(float v, int o, int lane) { return __int_as_float(__builtin_amdgcn_ds_bpermute((lane ^ o) << 2, __float_as_int(v))); }
__device__ __forceinline__ float shup(float v, int o, int lane) { return __int_as_float(__builtin_amdgcn_ds_bpermute((lane - o) << 2, __float_as_int(v))); }
__device__ __forceinline__ int shupi(int v, int o, int lane) { return __builtin_amdgcn_ds_bpermute((lane - o) << 2, v); }
__device__ __forceinline__ float wave_sum(float v, int lane) {
#pragma unroll
    for (int o = 1; o < 64; o <<= 1) v += shx(v, o, lane);
    return v;
}

#define XB_TMO      128
#define XB_XCNT(j)  (256  + 64 * (j))
#define XB_XSUB(j)  (1280 + 64 * (j))
#define XB_XGEN(j)  (2304 + 64 * (j))
#define XB_TOP      3328
#define XB_TOPGEN   3392
#define XCD_BAR_WORDS 3456
#define XB_SPIN_CAP (1u << 22)
__device__ __forceinline__ unsigned xb_ld(unsigned* p)              { return __hip_atomic_load(p, __ATOMIC_RELAXED, __HIP_MEMORY_SCOPE_AGENT); }
__device__ __forceinline__ unsigned xb_add(unsigned* p, unsigned v) { return __hip_atomic_fetch_add(p, v, __ATOMIC_RELAXED, __HIP_MEMORY_SCOPE_AGENT); }
__device__ __forceinline__ unsigned xb_xcc_id() { return (unsigned)__builtin_amdgcn_s_getreg((3 << 11) | 20) & 0xFu; }
#define XB_SPIN(cond, bar) do { unsigned _sp = 0; while (cond) { __builtin_amdgcn_s_sleep(1); \
    if ((++_sp & 255u) == 0u) { if (xb_ld(&(bar)[XB_TMO])) break; if (_sp > XB_SPIN_CAP) { atomicAdd(&(bar)[XB_TMO], 1u); break; } } } } while (0)
struct XcdBarrier { unsigned* bar; unsigned x; volatile LAS unsigned* st; };
__device__ __forceinline__ XcdBarrier xcd_barrier_post(unsigned* bar, volatile LAS unsigned* st) {
    XcdBarrier b; b.bar = bar; b.x = xb_xcc_id(); b.st = st;
    if (threadIdx.x == 0) (void)xb_add(&bar[XB_XCNT(b.x)], 1u);
    return b;
}
__device__ __forceinline__ void xcd_barrier_complete(unsigned* bar, unsigned x, unsigned& nloc, unsigned& nx) {
    const unsigned G = gridDim.x * gridDim.y * gridDim.z;
    unsigned sum, cnt, mine, sp = 0u;
    for (;;) {
        sum = 0u; cnt = 0u; mine = 0u;
#pragma unroll 1
        for (unsigned j = 0; j < 16; ++j) { const unsigned c = xb_ld(&bar[XB_XCNT(j)]); sum += c; cnt += (c > 0u) ? 1u : 0u; mine = (j == x) ? c : mine; }
        if (sum == G) break;
        __builtin_amdgcn_s_sleep(1);
        if ((++sp & 255u) == 0u) { if (xb_ld(&bar[XB_TMO])) break; if (sp > XB_SPIN_CAP) { atomicAdd(&bar[XB_TMO], 1u); break; } }
    }
    nloc = mine > 0u ? mine : 1u; nx = cnt > 0u ? cnt : 1u;
}
__device__ __forceinline__ int lane_now() { int l; asm volatile("v_mbcnt_lo_u32_b32 %0, -1, 0\n\tv_mbcnt_hi_u32_b32 %0, -1, %0" : "=v"(l)); return l; }
__device__ __forceinline__ void xcd_barrier(const XcdBarrier& b, int wave) {
    asm volatile("s_waitcnt vmcnt(0)" ::: "memory");
    __syncthreads();
    if (wave == 0 && lane_now() == 0) {
        unsigned* bar = b.bar;
        __builtin_amdgcn_s_waitcnt(0);
        unsigned nloc = b.st[0], nx = b.st[1];
        if (nloc == 0u) { xcd_barrier_complete(bar, b.x, nloc, nx); b.st[0] = nloc; b.st[1] = nx; }
        const unsigned old = xb_add(&bar[XB_XSUB(b.x)], 1u);
        const unsigned gen = old / nloc;
        if (old + 1u == (gen + 1u) * nloc) {
            __builtin_amdgcn_fence(__ATOMIC_RELEASE, "agent");
            asm volatile("s_waitcnt vmcnt(0)" ::: "memory");
            const unsigned og = xb_add(&bar[XB_TOP], 1u);
            const unsigned tg = og / nx;
            if (og + 1u == (tg + 1u) * nx) xb_add(&bar[XB_TOPGEN], 1u);
            else XB_SPIN(xb_ld(&bar[XB_TOPGEN]) == tg, bar);
            xb_add(&bar[XB_XGEN(b.x)], 1u);
            __builtin_amdgcn_fence(__ATOMIC_ACQUIRE, "agent");
            asm volatile("s_waitcnt vmcnt(0)" ::: "memory");
        } else {
            XB_SPIN(xb_ld(&bar[XB_XGEN(b.x)]) == gen, bar);
            __builtin_amdgcn_fence(__ATOMIC_ACQUIRE, "agent");
            asm volatile("s_waitcnt vmcnt(0)" ::: "memory");
        }
    }
    __syncthreads();
}

struct Args { const float* in[14]; float* out; unsigned char* ws; int lo, hi; };
struct Ctx {
    int tid, lane, wave, G, bid, gw, NGW;
    LAS unsigned char* lds;
    unsigned char* ws; float* out;
    const float* const* in;
    int layer, chunk, row0;
    int dry;
};
#define X_IN(c, i) ((c).in[i])
#define P_X(c) X_IN(c, 0)
#define P_NORMG(c) X_IN(c, 1)
#define P_WIN(c) X_IN(c, 2)
#define P_BF(c) X_IN(c, 3)
#define P_GCQ(c) X_IN(c, 4)
#define P_WUQ(c) X_IN(c, 5)
#define P_WUQI(c) X_IN(c, 6)
#define P_GCKV(c) X_IN(c, 7)
#define P_WUKV(c) X_IN(c, 8)
#define P_WA(c) X_IN(c, 9)
#define P_WB(c) X_IN(c, 10)
#define P_WC(c) X_IN(c, 11)
#define P_WO(c) X_IN(c, 12)
#define P_FG(c) X_IN(c, 13)
#define CHP(c, off) ((c).ws + WS_CH + (off))
#define B_QKVA(c) ((bf16*)CHP(c, O_QKVA))
#define B_QKVC(c) ((bf16*)CHP(c, O_QKVC))
#define B_QB(c) ((bf16*)CHP(c, O_QB))
#define B_QI(c) ((bf16*)CHP(c, O_QI))
#define B_CKV(c) ((bf16*)CHP(c, O_CKV))
#define B_KI(c) ((bf16*)CHP(c, O_KI))
#define B_WF(c) ((float*)CHP(c, O_WF))
#define B_SSQC(c) ((float*)CHP(c, O_SSQC))
#define B_KVB(c) ((bf16*)CHP(c, O_KVB))
#define B_CUM(c) ((float*)CHP(c, O_CUM))
#define B_ZY(c) ((bf16*)CHP(c, O_ZY))
#define B_G(c) ((bf16*)CHP(c, O_G))
#define B_MASK(c) ((unsigned*)CHP(c, O_MASK))
#define B_LSE(c) ((float*)CHP(c, O_LSE))
#define B_MRG(c) ((bf16*)CHP(c, O_MRG))
#define B_W1T(c) ((bf16*)((c).ws + WS_W1T) + (size_t)(c).layer * N1 * 1024)
#define B_WAT(c) ((bf16*)((c).ws + WS_WAT) + (size_t)(c).layer * 1024 * 512)
#define B_WBT(c) ((bf16*)((c).ws + WS_WBT) + (size_t)(c).layer * 1024 * 512)
#define B_WCT(c) ((bf16*)((c).ws + WS_WCT) + (size_t)(c).layer * 1024 * 768)
#define B_WOT(c) ((bf16*)((c).ws + WS_WOT) + (size_t)(c).layer * 1024 * 1024)
#define B_WKVT(c) ((bf16*)((c).ws + WS_WKVT) + (size_t)(c).layer * 128 * 128)
#define B_XB(c) ((bf16*)((c).ws + WS_XB))
#define B_SSQ(c) ((unsigned long long*)((c).ws + WS_SSQ) + (size_t)(c).layer * MALL)
__device__ __forceinline__ void ctx_set(Ctx& c, int layer, int chunk) { c.layer = layer; c.chunk = chunk; c.row0 = chunk * TC; }

template <class ColFn>
__device__ __forceinline__ void tr_item(const float* W, int ldw, const float* gain, bf16* WT, int K, int NB32, int item, LAS float* scr, int lane, ColFn colf, unsigned* cmax = nullptr) {
    const int kb = item / NB32, nb = item % NB32, k0 = 64 * kb, n0 = 32 * nb;
    const int c4 = 4 * (lane & 7), sc = colf(n0 + c4);
    f32x4 v[8];
#pragma unroll
    for (int i = 0; i < 8; ++i) { const int kk = 8 * i + (lane >> 3);
        v[i] = sc >= 0 ? *(const f32x4*)(W + (size_t)(k0 + kk) * ldw + sc) : (f32x4){0.f, 0.f, 0.f, 0.f}; }
    float gv[8];
#pragma unroll
    for (int i = 0; i < 8; ++i) gv[i] = gain ? gain[k0 + 8 * i + (lane >> 3)] : 1.0f;
    f32x4 mx = {0.f, 0.f, 0.f, 0.f};
#pragma unroll
    for (int i = 0; i < 8; ++i) { const int kk = 8 * i + (lane >> 3); f32x4 q = v[i]; if (gain) q = q * gv[i];
        mx.x = fmaxf(mx.x, fabsf(q.x)); mx.y = fmaxf(mx.y, fabsf(q.y)); mx.z = fmaxf(mx.z, fabsf(q.z)); mx.w = fmaxf(mx.w, fabsf(q.w));
        scr[kk * 33 + c4] = q.x; scr[kk * 33 + c4 + 1] = q.y; scr[kk * 33 + c4 + 2] = q.z; scr[kk * 33 + c4 + 3] = q.w; }
    if (cmax) {
#pragma unroll
        for (int o = 8; o < 64; o <<= 1) { mx.x = fmaxf(mx.x, shx(mx.x, o, lane)); mx.y = fmaxf(mx.y, shx(mx.y, o, lane)); mx.z = fmaxf(mx.z, shx(mx.z, o, lane)); mx.w = fmaxf(mx.w, shx(mx.w, o, lane)); }
        if (lane < 8) { unsigned* cp = cmax + n0 + c4;
            __hip_atomic_fetch_max(cp, __float_as_uint(mx.x), __ATOMIC_RELAXED, __HIP_MEMORY_SCOPE_AGENT); __hip_atomic_fetch_max(cp + 1, __float_as_uint(mx.y), __ATOMIC_RELAXED, __HIP_MEMORY_SCOPE_AGENT);
            __hip_atomic_fetch_max(cp + 2, __float_as_uint(mx.z), __ATOMIC_RELAXED, __HIP_MEMORY_SCOPE_AGENT); __hip_atomic_fetch_max(cp + 3, __float_as_uint(mx.w), __ATOMIC_RELAXED, __HIP_MEMORY_SCOPE_AGENT); } }
    asm volatile("s_waitcnt lgkmcnt(0)" ::: "memory");
    const int c = lane & 7;
#pragma unroll
    for (int j = 0; j < 4; ++j) { const int n = (lane >> 3) + 8 * j; const LAS float* s = scr + (8 * c) * 33 + n;
        u32x4 o; o.x = pk2(s[0 * 33], s[1 * 33]); o.y = pk2(s[2 * 33], s[3 * 33]); o.z = pk2(s[4 * 33], s[5 * 33]); o.w = pk2(s[6 * 33], s[7 * 33]);
        *(u32x4*)(WT + (size_t)(n0 + n) * K + k0 + 8 * c) = o; }
    asm volatile("s_waitcnt lgkmcnt(0)" ::: "memory");
}
__device__ __forceinline__ void comp_item(const float* w_in_l, const float* norm_g_l, const float* g_cq_l, const float* wu, int ldu, bf16* W1T_l, int nbase, int item, int lane, unsigned* cmax = nullptr) {
    const int jb = item >> 5, kb = item & 31, j0 = 32 * jb, k0 = 32 * kb;
    const int i = lane & 31, kk = lane >> 5;
    f32x16 acc = {};
    const float* ap = wu + (size_t)kk * ldu + j0 + i; const float* gp = g_cq_l + kk; const f32x4* bp4 = (const f32x4*)(w_in_l + (size_t)(k0 + i) * DIN + S_CQ);
#pragma unroll 1
    for (int s0 = 0; s0 < 128; s0 += 16) {
        float a[16]; f32x4 b4[8];
#pragma unroll
        for (int u = 0; u < 8; ++u) b4[u] = bp4[(s0 >> 1) + u];
#pragma unroll
        for (int u = 0; u < 16; ++u) { const int r2 = 2 * (s0 + u); a[u] = ap[(size_t)r2 * ldu] * gp[r2]; }
#pragma unroll
        for (int u = 0; u < 16; ++u) { const f32x4 q = b4[u >> 1]; const float bv = (u & 1) ? (kk ? q.w : q.z) : (kk ? q.y : q.x);
            acc = __builtin_amdgcn_mfma_f32_32x32x2f32(a[u], bv, acc, 0, 0, 0); }
    }
    const float gk = norm_g_l[k0 + i];
#pragma unroll
    for (int r = 0; r < 16; ++r) { const int j = (r & 3) + 8 * (r >> 2) + 4 * kk; const unsigned short hb = f2bf(acc[r] * gk);
        W1T_l[(size_t)(nbase + j0 + j) * 1024 + k0 + i] = (bf16)hb;
        if (cmax) {
            float m = fabsf(bf2f(hb));
#pragma unroll
            for (int o = 1; o < 32; o <<= 1) m = fmaxf(m, shx(m, o, lane));
            if (i == 0) __hip_atomic_fetch_max(cmax + nbase + j0 + j, __float_as_uint(m), __ATOMIC_RELAXED, __HIP_MEMORY_SCOPE_AGENT); } }
}

__device__ __forceinline__ unsigned q8(float v) { int i = (int)rintf(v); i = i < -127 ? -127 : (i > 127 ? 127 : i); return (unsigned)i & 255u; }
__device__ __forceinline__ unsigned pk4q(float a, float b, float c_, float d) { return q8(a) | (q8(b) << 8) | (q8(c_) << 16) | (q8(d) << 24); }
__device__ __forceinline__ void p0_prologue_b(Ctx& c) {
    for (int l = 0; l < 2; ++l) {
        const unsigned* cm = (const unsigned*)(c.ws + WS_CTL) + CW_CMAX + l * N1;
        const bf16* W1T_l = (const bf16*)(c.ws + WS_W1T) + (size_t)l * N1 * 1024; unsigned char* WQ = c.ws + WS_W1Q + (size_t)l * N1 * 1024;
        for (int nb = c.gw; nb < N1; nb += 2 * c.NGW) {
            const int n0 = nb, n1 = nb + c.NGW;
            const bool ok0 = !(n0 >= C_QI && n0 < C_Z), ok1 = n1 < N1 && !(n1 >= C_QI && n1 < C_Z);
            unsigned m0 = 0u, m1 = 0u; u32x4 a0 = {}, b0 = {}, a1 = {}, b1 = {};
            if (ok0) { m0 = cm[n0]; const u32x4* xp = (const u32x4*)(W1T_l + (size_t)n0 * 1024) + 2 * c.lane; a0 = xp[0]; b0 = xp[1]; }
            if (ok1) { m1 = cm[n1]; const u32x4* xp = (const u32x4*)(W1T_l + (size_t)n1 * 1024) + 2 * c.lane; a1 = xp[0]; b1 = xp[1]; }
#define P0B_ROW(ok_, n_, m_, a_, b_) if (ok_) { \
            const unsigned sb = (__float_as_uint(__uint_as_float(m_) * (1.0f / 127.0f)) + 0xFFFFu) >> 16;       \
            const float sc = __uint_as_float(sb << 16), inv = sc > 0.f ? 1.0f / sc : 0.f; \
            if (c.lane == 0) ((unsigned short*)((unsigned*)(c.ws + WS_CTL) + CW_CS16))[l * N1 + (n_)] = (unsigned short)sb; \
            u32x4 o; \
            o.x = pk4q(bflo(a_.x) * inv, bfhi(a_.x) * inv, bflo(a_.y) * inv, bfhi(a_.y) * inv); o.y = pk4q(bflo(a_.z) * inv, bfhi(a_.z) * inv, bflo(a_.w) * inv, bfhi(a_.w) * inv); \
            o.z = pk4q(bflo(b_.x) * inv, bfhi(b_.x) * inv, bflo(b_.y) * inv, bfhi(b_.y) * inv); o.w = pk4q(bflo(b_.z) * inv, bfhi(b_.z) * inv, bflo(b_.w) * inv, bfhi(b_.w) * inv); \
            *((u32x4*)(WQ + (size_t)(n_) * 1024) + c.lane) = o; }
            P0B_ROW(ok0, n0, m0, a0, b0) P0B_ROW(ok1, n1, m1, a1, b1)
#undef P0B_ROW
        }
    }
}
__device__ __forceinline__ void p0_prologue(Ctx& c) {
    LAS float* scr = (LAS float*)(c.lds + c.wave * 16384);
    int base = 0;
#define P0_DEAL(N_, BODY_) do { for (int it = (c.gw - base % c.NGW + c.NGW) % c.NGW; it < (N_); it += c.NGW) { BODY_; } base += (N_); } while (0)
    for (int l = 0; l < 2; ++l) {
        const float* w_in_l = P_WIN(c) + (size_t)l * D * DIN; const float* ng = P_NORMG(c) + l * D;
        bf16* W1T_l = (bf16*)(c.ws + WS_W1T) + (size_t)l * N1 * 1024;
        P0_DEAL(16 * 32, comp_item(w_in_l, ng, P_GCQ(c) + l * 256, P_WUQ(c) + (size_t)l * 256 * 512, 512, W1T_l, C_QB, it, c.lane, (unsigned*)(c.ws + WS_CTL) + CW_CMAX + l * N1));
        P0_DEAL(8 * 32, comp_item(w_in_l, ng, P_GCQ(c) + l * 256, P_WUQI(c) + (size_t)l * 256 * 256, 256, W1T_l, C_QI, it, c.lane));
    }
    for (int l = 0; l < 2; ++l) {
        const float* w_in_l = P_WIN(c) + (size_t)l * D * DIN; const float* ng = P_NORMG(c) + l * D;
        bf16* W1T_l = (bf16*)(c.ws + WS_W1T) + (size_t)l * N1 * 1024;
        P0_DEAL(16 * (N1 / 32), { const int nb = it % (N1 / 32);
            if (!(nb * 32 >= C_QB && nb * 32 < C_CKV)) tr_item(w_in_l, DIN, ng, W1T_l, 1024, N1 / 32, it, scr, c.lane, [](int n) { return src_col(n); }, (unsigned*)(c.ws + WS_CTL) + CW_CMAX + l * N1); });
        P0_DEAL(8 * 32, tr_item(P_WA(c) + (size_t)l * 512 * 1024, 1024, nullptr, (bf16*)(c.ws + WS_WAT) + (size_t)l * 1024 * 512, 512, 32, it, scr, c.lane, [](int n) { return n; }));
        P0_DEAL(8 * 32, tr_item(P_WB(c) + (size_t)l * 512 * 1024, 1024, nullptr, (bf16*)(c.ws + WS_WBT) + (size_t)l * 1024 * 512, 512, 32, it, scr, c.lane, [](int n) { return n; }));
        P0_DEAL(12 * 32, tr_item(P_WC(c) + (size_t)l * 768 * 1024, 1024, nullptr, (bf16*)(c.ws + WS_WCT) + (size_t)l * 1024 * 768, 768, 32, it, scr, c.lane, [](int n) { return n; }));
        P0_DEAL(16 * 32, tr_item(P_WO(c) + (size_t)l * 1024 * 1024, 1024, nullptr, (bf16*)(c.ws + WS_WOT) + (size_t)l * 1024 * 1024, 1024, 32, it, scr, c.lane, [](int n) { return n; }));
        P0_DEAL(2 * 4, tr_item(P_WUKV(c) + (size_t)l * 128 * 128, 128, P_GCKV(c) + l * 128, (bf16*)(c.ws + WS_WKVT) + (size_t)l * 128 * 128, 128, 4, it, scr, c.lane, [](int n) { return n; }));
    }
#undef P0_DEAL
    bf16* XB = (bf16*)(c.ws + WS_XB); unsigned long long* SSQ = (unsigned long long*)(c.ws + WS_SSQ);
    for (int m0 = c.gw * 4; m0 < MALL; m0 += c.NGW * 4) {
        f32x4 v[4][4];
#pragma unroll
        for (int r = 0; r < 4; ++r) { const f32x4* xr = (const f32x4*)(P_X(c) + (size_t)(m0 + r) * D) + c.lane;
#pragma unroll
            for (int j = 0; j < 4; ++j) v[r][j] = xr[64 * j]; }
#pragma unroll
        for (int r = 0; r < 4; ++r) { float s = 0.f; unsigned long long* o8 = (unsigned long long*)(XB + (size_t)(m0 + r) * D) + c.lane;
#pragma unroll
            for (int j = 0; j < 4; ++j) { const f32x4 q = v[r][j]; s += (q.x * q.x + q.y * q.y) + (q.z * q.z + q.w * q.w);
                o8[64 * j] = (unsigned long long)pk2(q.x, q.y) | ((unsigned long long)pk2(q.z, q.w) << 32); }
            s = wave_sum(s, c.lane);
            if (c.lane == 0) { SSQ[m0 + r] = (unsigned long long)(s * SSQ_SCALE + 0.5f); SSQ[MALL + m0 + r] = 0ull; SSQ[2 * MALL + m0 + r] = 0ull; }
            const float qs = __builtin_amdgcn_rsqf(s * (1.0f / D) + EPS) * XQ_SCALE; unsigned* xq = (unsigned*)(c.ws + WS_XQ + (size_t)(m0 + r) * 1024) + c.lane;
#pragma unroll
            for (int j = 0; j < 4; ++j) { const f32x4 q = v[r][j] * qs; xq[64 * j] = pk4q(q.x, q.y, q.z, q.w); } }
    }
}

__device__ __forceinline__ void st_bf4(bf16* p, f32x4 v) { *(u32x2*)p = (u32x2){pk2(v.x, v.y), pk2(v.z, v.w)}; }
__device__ __forceinline__ int perm_row(int row, int grp) {
    if (grp == 0) return row;
    const int b = row >> 11, t = row & 2047;
    return grp == 1 ? (b << 11) + ((t & 3) << 9) + (t >> 2) : (b << 11) + ((t & 15) << 7) + (t >> 4);
}
__device__ __forceinline__ float row_rstd(const unsigned long long* SSQ, int grow) {
    const float s = (float)SSQ[grow] * (1.0f / SSQ_SCALE);
    return __builtin_amdgcn_rsqf(s * (1.0f / D) + EPS);
}

namespace pg8 {
constexpr int BM = 256, BK = 64, HALF = 128, HTB = HALF * BK * 2, STAGE_BYTES = 8 * HTB, NXCD = 8, WGM = 8;
__host__ __device__ __forceinline__ int lds_byte(int r, int c) { const int st = (r >> 4) * 2 + (c >> 5), rr = r & 15, cc = c & 31, ob = rr * 64 + cc * 2; return st * 1024 + (ob ^ (((ob >> 9) & 1) << 5)); }
__host__ __device__ __forceinline__ void stage_rc(int b, int& R, int& C) { const int st = b / 1024, sb = b % 1024, swz = sb ^ (((sb >> 9) & 1) << 5); R = (st >> 1) * 16 + swz / 64; C = (st & 1) * 32 + (swz % 64) / 2; }
__host__ __device__ __forceinline__ int perm32(int rho) { const int n = rho >> 4, i = rho & 15; return 8 * (i >> 2) + 4 * n + (i & 3); }
struct Unit { int pm, pn; const char* A; const char* B; int lda, ldb, nt, aux; };
__device__ __forceinline__ unsigned cvt_pk_bf16(float lo, float hi) { unsigned r; asm volatile("v_cvt_pk_bf16_f32 %0, %1, %2" : "=v"(r) : "v"(lo), "v"(hi)); return r; }
__device__ __forceinline__ void glds2(const char* sbase, unsigned v0, unsigned v1, unsigned d0) { const unsigned d1 = d0 + 8192u;
    asm volatile("s_mov_b32 m0, %3\n\ts_nop 0\n\tglobal_load_lds_dwordx4 %1, %0\n\ts_mov_b32 m0, %4\n\ts_nop 0\n\tglobal_load_lds_dwordx4 %2, %0"
                 :: "s"(sbase), "v"(v0), "v"(v1), "s"(d0), "s"(d1) : "memory"); }
__device__ __forceinline__ bool tile_order(int nM, int nN, int G, int c, int i, int& pm, int& pn) {
    const int nwg = nM * nN; const long L = (long)i * G + c; if (L >= nwg) return false;
    int wgid = (int)L; { const int q = nwg / NXCD, r = nwg % NXCD, xcd = wgid % NXCD, off = wgid / NXCD; wgid = (xcd < r ? xcd * (q + 1) : r * (q + 1) + (xcd - r) * q) + off; }
    const int nig = WGM * nN, gid = wgid / nig, fm = gid * WGM, gsz = (nM - fm) < WGM ? (nM - fm) : WGM;
    pm = fm + ((wgid % nig) % gsz); pn = (wgid % nig) / gsz; return true;
}
template <class Epi, class Sched, bool ALIGN_EPI = true, bool I8 = false>
__device__ __forceinline__ void gemm_phase(LAS unsigned char* lds, const Sched& S, const Epi& E, int tid_in) {
    const int tid = tid_in, wid = __builtin_amdgcn_readfirstlane(tid >> 6), lane = tid & 63, wr = wid >> 2, wc = wid & 3, fr = lane & 15, fq = lane >> 4;
    int sR[2], sC[2], sRb[2];
#pragma unroll
    for (int i = 0; i < 2; ++i) { int R, C; stage_rc(tid * 16 + i * 8192, R, C); sR[i] = R; sC[i] = C; sRb[i] = Epi::PERM ? ((R & ~31) + perm32(R & 31)) : R; }
    const size_t kstep = (size_t)(BK * 2);
    const unsigned ldsb = (unsigned)__builtin_amdgcn_readfirstlane((int)((unsigned)(uintptr_t)lds + (unsigned)wid * 1024u));
    const int aoff = lds_byte(wr * 64 + fr, fq * 8), boff = lds_byte(wc * 32 + fr, fq * 8);
#define PG8_SA(b, h) (((b) * 2 + (h)) * HTB)
#define PG8_SB(b, h) ((4 + (b) * 2 + (h)) * HTB)
#define PG8_STAGE(bufoff, gbase, voff) pg8::glds2((const char*)(gbase), (voff)[0], (voff)[1], ldsb + (unsigned)(bufoff))
#define PG8_LDA(dst, b, h) do { _Pragma("unroll") for (int m = 0; m < 4; ++m) _Pragma("unroll") for (int k = 0; k < 2; ++k) dst[m][k] = *(const LAS bf16x8*)(lds + PG8_SA(b, h) + aoff + m * 2048 + k * 1024); } while (0)
#define PG8_LDB(dst, b, h) do { _Pragma("unroll") for (int n = 0; n < 2; ++n) _Pragma("unroll") for (int k = 0; k < 2; ++k) dst[n][k] = *(const LAS bf16x8*)(lds + PG8_SB(b, h) + boff + n * 2048 + k * 1024); } while (0)
#define PG8_MMA(ai, bj, At, Bt) do { __builtin_amdgcn_s_setprio(1); _Pragma("unroll") for (int m = 0; m < 4; ++m) _Pragma("unroll") for (int n = 0; n < 2; ++n) _Pragma("unroll") for (int k = 0; k < 2; ++k) { \
        if constexpr (I8) acc[ai][bj][m][n] = __builtin_bit_cast(f32x4, __builtin_amdgcn_mfma_i32_16x16x64_i8(__builtin_bit_cast(i32x4, Bt[n][k]), __builtin_bit_cast(i32x4, At[m][k]), __builtin_bit_cast(i32x4, acc[ai][bj][m][n]), 0, 0, 0)); \
        else acc[ai][bj][m][n] = __builtin_amdgcn_mfma_f32_16x16x32_bf16(Bt[n][k], At[m][k], acc[ai][bj][m][n], 0, 0, 0); } __builtin_amdgcn_s_setprio(0); } while (0)
#define PG8_WAIT_V(n) asm volatile("s_waitcnt vmcnt(" #n ")" ::: "memory")
#define PG8_WAIT_L(n) asm volatile("s_waitcnt lgkmcnt(" #n ")" ::: "memory")
#define PG8_WAIT_VR do { if (rl) PG8_WAIT_V(24); else PG8_WAIT_V(8); } while (0)
#define PG8_BAR __builtin_amdgcn_s_barrier()
#define PG8_SCHED __builtin_amdgcn_sched_barrier(0)
#define PG8_VOFF(u, va, vb) do { _Pragma("unroll") for (int _i = 0; _i < 2; ++_i) { va[_i] = (unsigned)(sR[_i] * (u).lda + sC[_i]) * 2u; vb[_i] = (unsigned)(sRb[_i] * (u).ldb + sC[_i]) * 2u; } } while (0)
    Unit cur, nxt; int ui = 0;
    if (!S.next(0, cur)) return;
    __builtin_amdgcn_s_waitcnt(0x0F70);
    f32x4 acc[2][2][4][2];
#pragma unroll
    for (int a = 0; a < 2; ++a)
#pragma unroll
        for (int b = 0; b < 2; ++b)
#pragma unroll
            for (int m = 0; m < 4; ++m)
#pragma unroll
                for (int n = 0; n < 2; ++n) acc[a][b][m][n] = (f32x4){__uint_as_float(Epi::ACC0), __uint_as_float(Epi::ACC0), __uint_as_float(Epi::ACC0), __uint_as_float(Epi::ACC0)};
    bf16x8 At[4][2], B0[2][2], B1[2][2];
    unsigned voffA[2], voffB[2], nvoffA[2], nvoffB[2];
    PG8_VOFF(cur, voffA, voffB);
    const char* cA = cur.A; const char* cB = cur.B;
    size_t hsA = (size_t)HALF * cur.lda * 2, hsB = (size_t)HALF * cur.ldb * 2;
    {
        PG8_STAGE(PG8_SB(0, 0), cB, voffB); PG8_STAGE(PG8_SB(0, 1), cB + hsB, voffB); PG8_STAGE(PG8_SA(0, 0), cA, voffA); PG8_STAGE(PG8_SA(0, 1), cA + hsA, voffA);
        if (wr == 1) PG8_BAR;
        PG8_WAIT_V(2); PG8_BAR;
        PG8_STAGE(PG8_SB(1, 0), cB + kstep, voffB); PG8_STAGE(PG8_SA(1, 0), cA + kstep, voffA); PG8_STAGE(PG8_SB(1, 1), cB + hsB + kstep, voffB); PG8_STAGE(PG8_SA(1, 1), cA + hsA + kstep, voffA);
        PG8_WAIT_V(0); PG8_BAR;
    }
    typename Epi::Pre pre;
    for (;;) {
        E.pre(pre, cur, wr, wc, fr, fq);
        const bool has_next = S.next(ui + 1, nxt);
        if (!has_next) nxt = cur;
        const char* nA = nxt.A; const char* nB = nxt.B;
        PG8_VOFF(nxt, nvoffA, nvoffB);
        const size_t nhsA = (size_t)HALF * nxt.lda * 2, nhsB = (size_t)HALF * nxt.ldb * 2;
        const int nt = cur.nt;
        for (int t = 0; t < nt; t += 2) {
            const bool last = (t == nt - 2);
            const char* a2 = last ? nA : cA + (size_t)(t + 2) * kstep; const char* b2 = last ? nB : cB + (size_t)(t + 2) * kstep;
            const char* a3 = a2 + kstep; const char* b3 = b2 + kstep;
            const size_t hA2 = last ? nhsA : hsA, hB2 = last ? nhsB : hsB;
            unsigned vA2[2], vB2[2];
#pragma unroll
            for (int _i = 0; _i < 2; ++_i) { vA2[_i] = last ? nvoffA[_i] : voffA[_i]; vB2[_i] = last ? nvoffB[_i] : voffB[_i]; }
            const bool rl = (t == 0);
            PG8_LDB(B0, 0, 0); PG8_LDB(B1, 0, 1); PG8_SCHED; PG8_LDA(At, 0, 0);
            PG8_WAIT_VR; PG8_WAIT_L(0); PG8_BAR; PG8_MMA(0, 0, At, B0); PG8_MMA(0, 1, At, B1); PG8_BAR; PG8_SCHED;
            PG8_LDA(At, 0, 1); PG8_STAGE(PG8_SB(0, 0), b2, vB2); PG8_STAGE(PG8_SB(0, 1), b2 + hB2, vB2); PG8_STAGE(PG8_SA(0, 0), a2, vA2);
            PG8_WAIT_VR; PG8_WAIT_L(0); PG8_BAR; PG8_MMA(1, 0, At, B0); PG8_MMA(1, 1, At, B1); PG8_BAR; PG8_SCHED;
            PG8_LDB(B0, 1, 0); PG8_LDB(B1, 1, 1); PG8_SCHED; PG8_LDA(At, 1, 0); PG8_STAGE(PG8_SA(0, 1), a2 + hA2, vA2);
            PG8_WAIT_VR; PG8_WAIT_L(0); PG8_BAR; PG8_MMA(0, 0, At, B0); PG8_MMA(0, 1, At, B1); PG8_BAR; PG8_SCHED;
            PG8_LDA(At, 1, 1); PG8_STAGE(PG8_SB(1, 0), b3, vB2); PG8_STAGE(PG8_SB(1, 1), b3 + hB2, vB2); PG8_STAGE(PG8_SA(1, 0), a3, vA2);
            PG8_WAIT_V(8); PG8_WAIT_L(0); PG8_BAR; PG8_MMA(1, 0, At, B0); PG8_MMA(1, 1, At, B1); PG8_BAR; PG8_SCHED;
            PG8_STAGE(PG8_SA(1, 1), a3 + hA2, vA2);
        }
        if constexpr (ALIGN_EPI) { if (wr == 0) PG8_BAR; }
        E(acc, cur, wr, wc, fr, fq, pre);
        if (!has_next) break;
        if (!(Epi::CHAIN && nxt.aux != 0)) {
#pragma unroll
        for (int a = 0; a < 2; ++a)
#pragma unroll
            for (int b = 0; b < 2; ++b)
#pragma unroll
                for (int m = 0; m < 4; ++m)
#pragma unroll
                    for (int n = 0; n < 2; ++n) acc[a][b][m][n] = (f32x4){__uint_as_float(Epi::ACC0), __uint_as_float(Epi::ACC0), __uint_as_float(Epi::ACC0), __uint_as_float(Epi::ACC0)};
        }
        cur = nxt; cA = nA; cB = nB; hsA = nhsA; hsB = nhsB; ++ui;
#pragma unroll
        for (int _i = 0; _i < 2; ++_i) { voffA[_i] = nvoffA[_i]; voffB[_i] = nvoffB[_i]; }
        if constexpr (ALIGN_EPI) { if (wr == 1) PG8_BAR; }
    }
    PG8_WAIT_V(0);
    if constexpr (!ALIGN_EPI) { if (wr == 0) PG8_BAR; }
    PG8_BAR;
#undef PG8_SA
#undef PG8_SB
#undef PG8_STAGE
#undef PG8_LDA
#undef PG8_LDB
#undef PG8_MMA
#undef PG8_WAIT_V
#undef PG8_WAIT_VR
#undef PG8_WAIT_L
#undef PG8_BAR
#undef PG8_SCHED
#undef PG8_VOFF
}
}

struct UniSched {
    const char* A; const char* B; int lda, ldb, nt, nM, nN, G, cid;
    __device__ __forceinline__ bool next(int i, pg8::Unit& u) const {
        int pm, pn; if (!pg8::tile_order(nM, nN, G, cid, i, pm, pn)) return false;
        u.pm = pm; u.pn = pn; u.A = A + (size_t)pm * 256 * lda * 2; u.B = B + (size_t)pn * 256 * ldb * 2; u.lda = lda; u.ldb = ldb; u.nt = nt; u.aux = 0; return true;
    }
};
struct SubSched {
    const char* A; const char* B; int lda, ldb, nt, nM, nN, G, cid, split, skip;
    __device__ __forceinline__ bool next(int i, pg8::Unit& u) const {
        int pm, pl; if (!pg8::tile_order(nM, nN, G, cid, i, pm, pl)) return false;
        const int pn = pl < split ? pl : pl + skip;
        u.pm = pm; u.pn = pn; u.A = A + (size_t)pm * 256 * lda * 2; u.B = B + (size_t)pn * 256 * ldb * 2; u.lda = lda; u.ldb = ldb; u.nt = nt; u.aux = 0; return true;
    }
};
__device__ __forceinline__ u32x4 pack8(f32x4 a, f32x4 b) { u32x4 w; w.x = pg8::cvt_pk_bf16(a.x, a.y); w.y = pg8::cvt_pk_bf16(a.z, a.w); w.z = pg8::cvt_pk_bf16(b.x, b.y); w.w = pg8::cvt_pk_bf16(b.z, b.w); return w; }
__device__ __forceinline__ f32x4 sig4(f32x4 v) { return (f32x4){sigmoidf_(v.x), sigmoidf_(v.y), sigmoidf_(v.z), sigmoidf_(v.w)}; }
__device__ __forceinline__ f32x4 sigt4(f32x4 t) {
    const f32x4 d = (f32x4){__builtin_amdgcn_exp2f(t.x), __builtin_amdgcn_exp2f(t.y), __builtin_amdgcn_exp2f(t.z), __builtin_amdgcn_exp2f(t.w)} + 1.0f;
    return (f32x4){__builtin_amdgcn_rcpf(d.x), __builtin_amdgcn_rcpf(d.y), __builtin_amdgcn_rcpf(d.z), __builtin_amdgcn_rcpf(d.w)}; }
__device__ __forceinline__ f32x4 silu4(f32x4 v) { return (f32x4){siluf_(v.x), siluf_(v.y), siluf_(v.z), siluf_(v.w)}; }
template <bool I8> struct EpiP1 {
    static constexpr bool PERM = true, CHAIN = false; static constexpr unsigned ACC0 = I8 ? 0x4B400000u : 0u;
    unsigned char* ws; int row0, layer; LAS unsigned char* lds;
    struct Pre {}; __device__ __forceinline__ void pre(Pre&, const pg8::Unit&, int, int, int, int) const {}
    __device__ __forceinline__ int operator()(const f32x4 (&acc)[2][2][4][2], const pg8::Unit& u, int wr, int wc, int fr, int fq, const Pre&) const {
        asm volatile("" : "+v"(fr), "+v"(fq));
        const int rowb = u.pm * 256 + wr * 64 + fr, pn = u.pn, cl = wc * 32 + 8 * fq;
        const unsigned long long* SSQ = (const unsigned long long*)(ws + WS_SSQ) + (size_t)layer * MALL;
        float rs[2][4]; f32x4 cs[2][2];
        if constexpr (I8) {
#pragma unroll
            for (int ai = 0; ai < 2; ++ai)
#pragma unroll
                for (int m = 0; m < 4; ++m) rs[ai][m] = 1.0f;
        } else {
            unsigned long long q0 = SSQ[row0 + rowb], q1 = SSQ[row0 + rowb + 16], q2 = SSQ[row0 + rowb + 32], q3 = SSQ[row0 + rowb + 48],
                               q4 = SSQ[row0 + rowb + 128], q5 = SSQ[row0 + rowb + 144], q6 = SSQ[row0 + rowb + 160], q7 = SSQ[row0 + rowb + 176];
            asm volatile("" : "+v"(q0), "+v"(q1), "+v"(q2), "+v"(q3), "+v"(q4), "+v"(q5), "+v"(q6), "+v"(q7));
            const unsigned long long q[8] = {q0, q1, q2, q3, q4, q5, q6, q7};
#pragma unroll
            for (int ai = 0; ai < 2; ++ai)
#pragma unroll
                for (int m = 0; m < 4; ++m) rs[ai][m] = __builtin_amdgcn_rsqf((float)q[ai * 4 + m] * (1.0f / SSQ_SCALE) * (1.0f / D) + EPS);
        }
        if constexpr (I8) { const LAS unsigned short* cm = (const LAS unsigned short*)(lds + L_CS16) + pn * 256 + cl;
#pragma unroll
            for (int bj = 0; bj < 2; ++bj) { const u32x4 q = *(const LAS u32x4*)(cm + bj * 128); const float k_ = XCLIP / 127.0f;
                cs[bj][0] = (f32x4){bflo(q.x) * k_, bfhi(q.x) * k_, bflo(q.y) * k_, bfhi(q.y) * k_}; cs[bj][1] = (f32x4){bflo(q.z) * k_, bfhi(q.z) * k_, bflo(q.w) * k_, bfhi(q.w) * k_}; } }
#define P1V(ai, bj, m, n) (I8 ? (acc[ai][bj][m][n] + -12582912.0f) * cs[bj][n] : acc[ai][bj][m][n])
#define P1W(ai, bj, m, n, r_) (I8 ? acc[ai][bj][m][n] * cs[bj][n] + co[bj][n] : acc[ai][bj][m][n] * (r_))
        unsigned char* ch = ws + WS_CH;
        if (I8 && pn == 15) {
            float* SSQC = (float*)(ch + O_SSQC); float* SSQD = (float*)(ws + WS_PAD16);
#pragma unroll
            for (int ai = 0; ai < 2; ++ai)
#pragma unroll
                for (int m = 0; m < 4; ++m) { float s = 0.f;
#pragma unroll
                    for (int bj = 0; bj < 2; ++bj)
#pragma unroll
                        for (int n = 0; n < 2; ++n) { const f32x4 v = P1V(ai, bj, m, n) * rs[ai][m]; s += (v.x * v.x + v.y * v.y) + (v.z * v.z + v.w * v.w); }
                    s += shx(s, 16, fr + 16 * fq); s += shx(s, 32, fr + 16 * fq);
                    if (fq == 0) { SSQC[(size_t)(rowb + ai * 128 + m * 16) * 8 + wc] = s; SSQD[(size_t)(rowb + ai * 128 + m * 16) * 8 + wc] = s; } }
            return 16;
        }
        if (!I8 && pn == 19) {
            float* SSQC = (float*)(ch + O_SSQC); bf16* CKV = (bf16*)(ch + O_CKV); bf16* KI = (bf16*)(ch + O_KI); float* WF = (float*)(ch + O_WF);
#pragma unroll
            for (int ai = 0; ai < 2; ++ai)
#pragma unroll
                for (int m = 0; m < 4; ++m) { const int row = rowb + ai * 128 + m * 16; const float r = rs[ai][m];
                    const f32x4 v0 = P1V(ai, 0, m, 0) * r, v1 = P1V(ai, 0, m, 1) * r;
                    *(u32x4*)(CKV + (size_t)row * 128 + cl) = pack8(v0, v1);
                    float s = ((v0.x * v0.x + v0.y * v0.y) + (v0.z * v0.z + v0.w * v0.w)) + ((v1.x * v1.x + v1.y * v1.y) + (v1.z * v1.z + v1.w * v1.w));
                    s += shx(s, 16, fr + 16 * fq); s += shx(s, 32, fr + 16 * fq);
                    if (fq == 0) SSQC[(size_t)row * 8 + 4 + wc] = s;
                    const f32x4 w0 = P1V(ai, 1, m, 0) * r, w1 = P1V(ai, 1, m, 1) * r;
                    if (wc == 0) *(u32x4*)(KI + (size_t)row * 32 + 8 * fq) = pack8(w0, w1);
                    else if (wc == 1 && fq < 2) { *(f32x4*)(WF + (size_t)row * 16 + 8 * fq) = w0; *(f32x4*)(WF + (size_t)row * 16 + 8 * fq + 4) = w1; } }
            return 16;
        }
        bf16* dst; int ld, cb, act = 0, lg = 0; float sc = 1.f;
        if (pn < 6) { dst = (bf16*)(ch + O_QKVA); ld = 1536; cb = pn * 256; if (pn < 2) sc = QS; }
        else if (pn < 15) { dst = (bf16*)(ch + O_QKVC); ld = 2304; cb = (pn - 6) * 256; lg = 2 * ((pn - 6) % 3); if (pn < 9) sc = QS; }
        else if (pn < 18) { dst = (bf16*)(ch + O_QB); ld = 512; cb = (pn - 16) * 256; sc = QS; }
        else if (pn == 18) { dst = (bf16*)(ch + O_QI); ld = 256; cb = 0; }
        else if (pn < 27) { dst = (bf16*)(ch + O_ZY); ld = 1792; cb = (pn - 20) * 256; act = 1; }
        else { dst = (bf16*)(ch + O_G); ld = 3072; cb = (pn - 27) * 256; act = 2; }
        if constexpr (I8) { if (sc != 1.f) {
#pragma unroll
            for (int bj = 0; bj < 2; ++bj)
#pragma unroll
                for (int n = 0; n < 2; ++n) cs[bj][n] = cs[bj][n] * sc; } }
        f32x4 csn[2][2];
#pragma unroll
        for (int bj = 0; bj < 2; ++bj)
#pragma unroll
            for (int n = 0; n < 2; ++n) csn[bj][n] = I8 ? cs[bj][n] * -LOG2E : (f32x4){0.f, 0.f, 0.f, 0.f};
        f32x4 co[2][2], con[2][2];
#pragma unroll
        for (int bj = 0; bj < 2; ++bj)
#pragma unroll
            for (int n = 0; n < 2; ++n) { co[bj][n] = cs[bj][n] * -12582912.0f; con[bj][n] = csn[bj][n] * -12582912.0f; }
#define P1T(ai, bj, m, n, r_) (I8 ? acc[ai][bj][m][n] * csn[bj][n] + con[bj][n] : acc[ai][bj][m][n] * ((r_) * -LOG2E))
#define P1_BODY(ACT) do { _Pragma("unroll") for (int ai = 0; ai < 2; ++ai) _Pragma("unroll") for (int m = 0; m < 4; ++m) { \
                const int row = rowb + ai * 128 + m * 16; const float r = rs[ai][m] * sc; const int b_ = row >> 11, t_ = row & 2047; \
                const int prow = (b_ << 11) + ((t_ & ((1 << lg) - 1)) << (11 - lg)) + (t_ >> lg); \
                bf16* rp = dst + (size_t)prow * ld + cb + cl; \
                _Pragma("unroll") for (int bj = 0; bj < 2; ++bj) { f32x4 v0 = P1W(ai, bj, m, 0, r), v1 = P1W(ai, bj, m, 1, r); \
                    if (ACT == 2) {     \
                          \
                        v0 = sigt4(P1T(ai, bj, m, 0, r)) * 255.0f + 8388608.0f; v1 = sigt4(P1T(ai, bj, m, 1, r)) * 255.0f + 8388608.0f; \
                        v0.x = fmaxf(v0.x, 8388609.f); v0.y = fmaxf(v0.y, 8388609.f); v0.z = fmaxf(v0.z, 8388609.f); v0.w = fmaxf(v0.w, 8388609.f); v1.x = fmaxf(v1.x, 8388609.f); v1.y = fmaxf(v1.y, 8388609.f); v1.z = fmaxf(v1.z, 8388609.f); v1.w = fmaxf(v1.w, 8388609.f); \
                        const unsigned lo = __builtin_amdgcn_perm(__float_as_uint(v0.y), __float_as_uint(v0.x), 0x0c0c0400u) | __builtin_amdgcn_perm(__float_as_uint(v0.w), __float_as_uint(v0.z), 0x04000c0cu), \
                                       hi_ = __builtin_amdgcn_perm(__float_as_uint(v1.y), __float_as_uint(v1.x), 0x0c0c0400u) | __builtin_amdgcn_perm(__float_as_uint(v1.w), __float_as_uint(v1.z), 0x04000c0cu); \
                        *(u32x2*)((unsigned char*)(ch + O_G) + (size_t)row * 3072 + cb + cl + bj * 128) = (u32x2){lo, hi_}; } \
                    else { if (ACT == 1) { v0 = v0 * sigt4(P1T(ai, bj, m, 0, r)); v1 = v1 * sigt4(P1T(ai, bj, m, 1, r)); } \
                        *(u32x4*)(rp + bj * 128) = pack8(v0, v1); } } } } while (0)
        if (act == 0) P1_BODY(0); else if (act == 1) P1_BODY(1); else P1_BODY(2);
#undef P1_BODY
#undef P1T
        return 16;
    }
};
#undef P1V
#undef P1W
struct EpiOut {
    static constexpr bool PERM = true, CHAIN = false; static constexpr unsigned ACC0 = 0u;
    unsigned char* ws; int row0; int layer;
    struct Pre {}; __device__ __forceinline__ void pre(Pre&, const pg8::Unit&, int, int, int, int) const {}
    __device__ __forceinline__ int operator()(const f32x4 (&acc)[2][2][4][2], const pg8::Unit& u, int wr, int wc, int fr, int fq, const Pre&) const {
        asm volatile("" : "+v"(fr), "+v"(fq));
        const int rowb = row0 + u.pm * 256 + wr * 64 + fr, cl = u.pn * 256 + wc * 32 + 8 * fq;
        bf16* XB = (bf16*)(ws + WS_XB) + cl; unsigned long long* SSQ1 = (unsigned long long*)(ws + WS_SSQ) + (size_t)(layer + 1) * MALL;
        u32x4 xo[2][4][2];
#pragma unroll
        for (int ai = 0; ai < 2; ++ai)
#pragma unroll
            for (int m = 0; m < 4; ++m) { const bf16* xp = XB + (size_t)(rowb + ai * 128 + m * 16) * D; xo[ai][m][0] = *(const u32x4*)xp; xo[ai][m][1] = *(const u32x4*)(xp + 128); }
        asm volatile("" : "+v"(xo[0][0][0]), "+v"(xo[0][0][1]), "+v"(xo[0][1][0]), "+v"(xo[0][1][1]), "+v"(xo[0][2][0]), "+v"(xo[0][2][1]), "+v"(xo[0][3][0]), "+v"(xo[0][3][1]),
                          "+v"(xo[1][0][0]), "+v"(xo[1][0][1]), "+v"(xo[1][1][0]), "+v"(xo[1][1][1]), "+v"(xo[1][2][0]), "+v"(xo[1][2][1]), "+v"(xo[1][3][0]), "+v"(xo[1][3][1]));
#pragma unroll
        for (int ai = 0; ai < 2; ++ai) {
#pragma unroll
            for (int m = 0; m < 4; ++m) { const int row = rowb + ai * 128 + m * 16; bf16* xp = XB + (size_t)row * D; float s = 0.f;
#pragma unroll
                for (int bj = 0; bj < 2; ++bj) { const u32x4 x4 = xo[ai][m][bj];
                    const f32x4 a = (f32x4){bflo(x4.x), bfhi(x4.x), bflo(x4.y), bfhi(x4.y)} + acc[ai][bj][m][0], b = (f32x4){bflo(x4.z), bfhi(x4.z), bflo(x4.w), bfhi(x4.w)} + acc[ai][bj][m][1];
                    *(u32x4*)(xp + bj * 128) = pack8(a, b);
                    s += ((a.x * a.x + a.y * a.y) + (a.z * a.z + a.w * a.w)) + ((b.x * b.x + b.y * b.y) + (b.z * b.z + b.w * b.w)); }
                s += shx(s, 16, fr + 16 * fq); s += shx(s, 32, fr + 16 * fq);
                if (fq == 0) __hip_atomic_fetch_add(SSQ1 + row, (unsigned long long)(s * SSQ_SCALE + 0.5f), __ATOMIC_RELAXED, __HIP_MEMORY_SCOPE_AGENT); }
        }
        return 16;
    }
};


struct MrgSched {
    unsigned char* ws; int layer, nM, nN, G, cid;
    __device__ __forceinline__ bool next(int i, pg8::Unit& u) const {
        const int tile = i / 3, which = i - 3 * tile; int pm, pn; if (!pg8::tile_order(nM, nN, G, cid, tile, pm, pn)) return false;
        u.pm = pm; u.pn = pn; u.lda = 1792; u.ldb = which == 2 ? 768 : 512; u.nt = u.ldb / 64; u.aux = which;
        u.A = (const char*)(ws + WS_CH + O_ZY) + ((size_t)pm * 256 * 1792 + (which == 0 ? 0 : (which == 1 ? 512 : 1024))) * 2;
        const size_t wbase = which == 0 ? WS_WAT + (size_t)layer * 1024 * 512 * 2 : (which == 1 ? WS_WBT + (size_t)layer * 1024 * 512 * 2 : WS_WCT + (size_t)layer * 1024 * 768 * 2);
        u.B = (const char*)(ws + wbase) + (size_t)pn * 256 * u.ldb * 2; return true;
    }
};
struct EpiMrg {
    static constexpr bool PERM = true, CHAIN = true; static constexpr unsigned ACC0 = 0u;
    unsigned char* ws;
    struct Pre { u32x2 w0, w1, n0, n1, w2, w3, n2, n3; };
    __device__ __forceinline__ void pre(Pre& p, const pg8::Unit& u, int wr, int wc, int fr, int fq) const {
        const unsigned char* g = (const unsigned char*)(ws + WS_CH + O_G) + u.aux * 1024 + u.pn * 256 + wc * 32 + 8 * fq + (size_t)(u.pm * 256 + wr * 64 + fr) * 3072;
        p.w0 = *(const u32x2*)g; p.w1 = *(const u32x2*)(g + 128); p.w2 = *(const u32x2*)(g + 16 * 3072); p.w3 = *(const u32x2*)(g + 16 * 3072 + 128);
        if (u.aux < 2) { p.n0 = *(const u32x2*)(g + 1024); p.n1 = *(const u32x2*)(g + 1024 + 128); p.n2 = *(const u32x2*)(g + 16 * 3072 + 1024); p.n3 = *(const u32x2*)(g + 16 * 3072 + 1024 + 128); }
        else { p.n0 = p.w0; p.n1 = p.w1; p.n2 = p.w2; p.n3 = p.w3; }
    }
    __device__ __forceinline__ int operator()(f32x4 (&acc)[2][2][4][2], const pg8::Unit& u, int wr, int wc, int fr, int fq, const Pre& pr) const {
        asm volatile("" : "+v"(fr), "+v"(fq));
        const int which = u.aux, rowb = u.pm * 256 + wr * 64 + fr, cl = u.pn * 256 + wc * 32 + 8 * fq;
        const unsigned char* Gb = (const unsigned char*)(ws + WS_CH + O_G) + which * 1024 + cl; bf16* MRG = (bf16*)(ws + WS_CH + O_MRG) + cl;
        u32x2 gw[8][2], gn[8][2];
#define MRG_LOAD(g_, MID) do { const int row_ = rowb + ((g_) >> 2) * 128 + ((g_) & 3) * 16; \
        gw[g_][0] = *(const u32x2*)(Gb + (size_t)row_ * 3072); gw[g_][1] = *(const u32x2*)(Gb + (size_t)row_ * 3072 + 128); \
        if (MID) { gn[g_][0] = *(const u32x2*)(Gb + (size_t)row_ * 3072 + 1024); gn[g_][1] = *(const u32x2*)(Gb + (size_t)row_ * 3072 + 1024 + 128); } } while (0)
#define UB(w_, i_) ((float)(((w_) >> (8 * (i_))) & 255u))
#define RB(w_, i_) __builtin_amdgcn_rcpf((float)(((w_) >> (8 * (i_))) & 255u))
#define MRG_BODY(MID) do { gw[0][0] = pr.w0; gw[0][1] = pr.w1; gn[0][0] = pr.n0; gn[0][1] = pr.n1; gw[1][0] = pr.w2; gw[1][1] = pr.w3; gn[1][0] = pr.n2; gn[1][1] = pr.n3; MRG_LOAD(2, MID); MRG_LOAD(3, MID); MRG_LOAD(4, MID); \
        _Pragma("unroll") for (int g = 0; g < 8; ++g) { \
            asm volatile("" ::: "memory"); \
            if (g + 5 < 8) MRG_LOAD(g + 5, MID); \
            const int ai = g >> 2, m = g & 3, row = rowb + ai * 128 + m * 16; \
            _Pragma("unroll") for (int bj = 0; bj < 2; ++bj) { const u32x2 q = gw[g][bj]; \
                f32x4 s0 = (f32x4){UB(q.x, 0), UB(q.x, 1), UB(q.x, 2), UB(q.x, 3)}, s1 = (f32x4){UB(q.y, 0), UB(q.y, 1), UB(q.y, 2), UB(q.y, 3)}; \
                if (MID) { const u32x2 d = gn[g][bj]; \
                    acc[ai][bj][m][0] = acc[ai][bj][m][0] * (s0 * (f32x4){RB(d.x, 0), RB(d.x, 1), RB(d.x, 2), RB(d.x, 3)}); \
                    acc[ai][bj][m][1] = acc[ai][bj][m][1] * (s1 * (f32x4){RB(d.y, 0), RB(d.y, 1), RB(d.y, 2), RB(d.y, 3)}); } \
                else { const float k_ = 1.0f / 255.0f; \
                    *(u32x4*)(MRG + (size_t)row * 1024 + bj * 128) = pack8(acc[ai][bj][m][0] * (s0 * k_), acc[ai][bj][m][1] * (s1 * k_)); } } } } while (0)
        if (which < 2) MRG_BODY(1); else MRG_BODY(0);
#undef MRG_BODY
#undef RB
#undef UB
#undef MRG_LOAD
        return 16;
    }
};

__device__ __forceinline__ void final_norm_rows(const Ctx& c, int m_lo, int m_hi, int wv, int nwv) {
    const unsigned long long* SSQ2 = (const unsigned long long*)(c.ws + WS_SSQ) + 2 * (size_t)MALL;
    const f32x4* gp = (const f32x4*)P_FG(c) + 4 * c.lane; const f32x4 g0 = gp[0], g1 = gp[1], g2 = gp[2], g3 = gp[3];
    for (int m0 = m_lo + wv * 4; m0 < m_hi; m0 += nwv * 4) {
        u32x4 xa[4], xb[4]; float rs[4];
#pragma unroll
        for (int r = 0; r < 4; ++r) { const u32x4* xp = (const u32x4*)((const bf16*)(c.ws + WS_XB) + (size_t)(m0 + r) * D) + 2 * c.lane; xa[r] = xp[0]; xb[r] = xp[1]; rs[r] = row_rstd(SSQ2, m0 + r); }
#pragma unroll
        for (int r = 0; r < 4; ++r) { f32x4* op = (f32x4*)(c.out + (size_t)(m0 + r) * D) + 4 * c.lane; const float k = rs[r];
            op[0] = (f32x4){bflo(xa[r].x), bfhi(xa[r].x), bflo(xa[r].y), bfhi(xa[r].y)} * k * g0; op[1] = (f32x4){bflo(xa[r].z), bfhi(xa[r].z), bflo(xa[r].w), bfhi(xa[r].w)} * k * g1;
            op[2] = (f32x4){bflo(xb[r].x), bfhi(xb[r].x), bflo(xb[r].y), bfhi(xb[r].y)} * k * g2; op[3] = (f32x4){bflo(xb[r].z), bfhi(xb[r].z), bflo(xb[r].w), bfhi(xb[r].w)} * k * g3; }
    }
}

namespace att {
typedef short v4i16_t __attribute__((ext_vector_type(4)));
constexpr int SLOT = 8192, SLOT_V = 4096;
constexpr float THR = 8.0f, NEG_BIG = -1.0e30f, QK_BOUND = 48.0f, REL_REF0 = -4096.0f;
__device__ __forceinline__ int crow(int r, int hi) { return (r & 3) + 8 * (r >> 2) + 4 * hi; }
__device__ __forceinline__ void glds16(const void* gsrc, unsigned lds_dst) { unsigned keep;
    asm volatile("s_mov_b32 %0, m0\n\ts_mov_b32 m0, %2\n\ts_nop 0\n\tglobal_load_lds_dwordx4 %1, off\n\ts_mov_b32 m0, %0" : "=&s"(keep) : "v"(gsrc), "s"(lds_dst) : "memory"); }
__device__ __forceinline__ void dma_slot(LAS unsigned char* slot, const char* kbase, const char* vbase, long stride, int w, int lane) {
    const unsigned sb = (unsigned)(uintptr_t)slot;
    if (w < 4) { const char* s = kbase + (long)(lane & 31) * stride + (2 * w + (lane >> 5)) * 16;
        glds16(s, (unsigned)__builtin_amdgcn_readfirstlane((int)(sb + w * 1024))); }
    else { const int w2 = w - 4; const char* s = vbase + (long)(16 * (w2 & 1) + (lane >> 2)) * stride + (w2 >> 1) * 64 + (lane & 3) * 16;
        glds16(s, (unsigned)__builtin_amdgcn_readfirstlane((int)(sb + SLOT_V + w2 * 1024))); }
}
__device__ __forceinline__ void qk_slot(f32x16& p, LAS const unsigned char* slot, const bf16x8 (&qr)[4], int r32, int hi) {
#pragma unroll
    for (int d0 = 0; d0 < 4; ++d0) { const bf16x8 kf = *(LAS const bf16x8*)(slot + (2 * d0 + hi) * 512 + r32 * 16);
        p = __builtin_amdgcn_mfma_f32_32x32x16_bf16(kf, qr[d0], p, 0, 0, 0); }
}
__device__ __forceinline__ bf16x8 vfrag(LAS const unsigned char* vp) {
    const v4i16_t lo = __builtin_amdgcn_ds_read_tr16_b64_v4i16((LAS v4i16_t*)vp), hi = __builtin_amdgcn_ds_read_tr16_b64_v4i16((LAS v4i16_t*)(vp + 512));
    return (bf16x8){lo[0], lo[1], lo[2], lo[3], hi[0], hi[1], hi[2], hi[3]};
}
__device__ __forceinline__ bf16x8 pack_p(const f32x16& p, int b) {
    u32x4 w; w.x = pg8::cvt_pk_bf16(p[b], p[b + 1]); w.y = pg8::cvt_pk_bf16(p[b + 2], p[b + 3]); w.z = pg8::cvt_pk_bf16(p[b + 4], p[b + 5]); w.w = pg8::cvt_pk_bf16(p[b + 6], p[b + 7]);
    return __builtin_bit_cast(bf16x8, w);
}
__device__ __forceinline__ void pv_slot(f32x16& o0, f32x16& o1, const f32x16& p, LAS const unsigned char* slot, int voff) {
    const bf16x8 pa0 = pack_p(p, 0), pa1 = pack_p(p, 8);
    LAS const unsigned char* vp = slot + SLOT_V + voff;
    o0 = __builtin_amdgcn_mfma_f32_32x32x16_bf16(pa0, vfrag(vp), o0, 0, 0, 0);
    o1 = __builtin_amdgcn_mfma_f32_32x32x16_bf16(pa0, vfrag(vp + 2048), o1, 0, 0, 0);
    o0 = __builtin_amdgcn_mfma_f32_32x32x16_bf16(pa1, vfrag(vp + 1024), o0, 0, 0, 0);
    o1 = __builtin_amdgcn_mfma_f32_32x32x16_bf16(pa1, vfrag(vp + 3072), o1, 0, 0, 0);
}
__device__ __forceinline__ float max_halves(float v) { const auto r = __builtin_amdgcn_permlane32_swap(__float_as_uint(v), __float_as_uint(v), false, false); return fmaxf(__uint_as_float(r[0]), __uint_as_float(r[1])); }
__device__ __forceinline__ float sum_halves(float v) { const auto r = __builtin_amdgcn_permlane32_swap(__float_as_uint(v), __float_as_uint(v), false, false); return __uint_as_float(r[0]) + __uint_as_float(r[1]); }
struct St { float mref, l; f32x16 o0, o1; };
__device__ __forceinline__ void st_init(St& s) { s.mref = NEG_BIG; s.l = 0.f; s.o0 = f32x16{}; s.o1 = f32x16{}; }
__device__ __forceinline__ float max16(const f32x16& p) {
    float a = fmaxf(fmaxf(p[0], p[1]), p[2]), b = fmaxf(fmaxf(p[3], p[4]), p[5]);
    a = fmaxf(fmaxf(a, p[6]), p[7]); b = fmaxf(fmaxf(b, p[8]), p[9]); a = fmaxf(fmaxf(a, p[10]), p[11]); b = fmaxf(fmaxf(b, p[12]), p[13]);
    return fmaxf(fmaxf(a, b), fmaxf(p[14], p[15]));
}
__device__ __forceinline__ void sm_rescale(St& s, float tm, LAS float* wsf, int r32, int hi) {
    tm = max_halves(tm);
    const bool need = tm > s.mref + THR;
    if (__any(need)) {
        const float mn = need ? tm : s.mref, alpha = fexp2(s.mref - mn);
        s.mref = mn; s.l *= alpha;
        if (hi == 0) wsf[r32] = alpha;
        asm volatile("s_waitcnt lgkmcnt(0)" ::: "memory");
#pragma unroll
        for (int r = 0; r < 16; ++r) { const float a = wsf[crow(r, hi)]; s.o0[r] *= a; s.o1[r] *= a; }
    }
}
__device__ __forceinline__ void sm_rescale_rel(St& s, float tm, f32x16& pa, f32x16& pb, LAS float* wsf, int r32, int hi) {
    tm = max_halves(tm);
    const bool need = tm > THR;
    if (__any(need)) {
        const float delta = need ? tm : 0.f, alpha = fexp2(-delta);
        s.mref += delta; s.l *= alpha;
        if (hi == 0) wsf[r32] = alpha;
        asm volatile("s_waitcnt lgkmcnt(0)" ::: "memory");
#pragma unroll
        for (int r = 0; r < 16; ++r) { const float a = wsf[crow(r, hi)]; s.o0[r] *= a; s.o1[r] *= a; }
#pragma unroll
        for (int r = 0; r < 16; ++r) { pa[r] -= delta; pb[r] -= delta; }
    }
}
__device__ __forceinline__ void sm_rescale_rel(St& s, float tm, f32x16& pa, LAS float* wsf, int r32, int hi) {
    tm = max_halves(tm);
    const bool need = tm > THR;
    if (__any(need)) {
        const float delta = need ? tm : 0.f, alpha = fexp2(-delta);
        s.mref += delta; s.l *= alpha;
        if (hi == 0) wsf[r32] = alpha;
        asm volatile("s_waitcnt lgkmcnt(0)" ::: "memory");
#pragma unroll
        for (int r = 0; r < 16; ++r) { const float a = wsf[crow(r, hi)]; s.o0[r] *= a; s.o1[r] *= a; }
#pragma unroll
        for (int r = 0; r < 16; ++r) pa[r] -= delta;
    }
}
__device__ __forceinline__ void sm_exp_rel(St& s, f32x16& p) {
    float sum = 0.f;
#pragma unroll
    for (int r = 0; r < 16; ++r) { p[r] = fexp2(p[r]); sum += p[r]; }
    s.l += sum;
}
__device__ __forceinline__ void sm_exp(St& s, f32x16& p) {
    float sum = 0.f;
#pragma unroll
    for (int r = 0; r < 16; ++r) { p[r] = fexp2(p[r] - s.mref); sum += p[r]; }
    s.l += sum;
}
template <class RowFn>
__device__ __forceinline__ float finish(St& s, LAS float* wsf, LAS unsigned char* stg, bf16* zy_col, RowFn row_of, int lane, int r32, int hi, int dry = 0, const u32x4* zpre = nullptr) {
    u32x4 zv[4]; bf16* dstp[4];
#pragma unroll
    for (int i = 0; i < 4; ++i) { const int q = i * 8 + (lane >> 3), ch = lane & 7; dstp[i] = zy_col + (size_t)row_of(q) * 1792 + ch * 8; zv[i] = zpre ? zpre[i] : *(const u32x4*)dstp[i]; }
    float l = sum_halves(s.l);
    if (hi == 0) wsf[32 + r32] = __builtin_amdgcn_rcpf(l);
    asm volatile("s_waitcnt lgkmcnt(0)" ::: "memory");
    LAS bf16* st = (LAS bf16*)stg;
#pragma unroll
    for (int r = 0; r < 16; ++r) { const int q = crow(r, hi); const float rl = wsf[32 + q];
        st[q * 64 + r32] = (bf16)f2bf(s.o0[r] * rl); st[q * 64 + 32 + r32] = (bf16)f2bf(s.o1[r] * rl); }
    asm volatile("s_waitcnt lgkmcnt(0)" ::: "memory");
#pragma unroll
    for (int i = 0; i < 4; ++i) { const int q = i * 8 + (lane >> 3), ch = lane & 7;
        const u32x4 ov = *(LAS const u32x4*)(stg + q * 128 + ch * 16); const u32x4 z = zv[i]; u32x4 y;
        y.x = pk2(bflo(ov.x) * bflo(z.x), bfhi(ov.x) * bfhi(z.x)); y.y = pk2(bflo(ov.y) * bflo(z.y), bfhi(ov.y) * bfhi(z.y));
        y.z = pk2(bflo(ov.z) * bflo(z.z), bfhi(ov.z) * bfhi(z.z)); y.w = pk2(bflo(ov.w) * bflo(z.w), bfhi(ov.w) * bfhi(z.w));
        if (!dry) *(u32x4*)dstp[i] = y; }
    return s.mref + __log2f(l);
}
constexpr int L_RING = 0, L_CUM = 98304, L_WSF = 106496, L_STG = 110592, L_SQ = 131072, L_SW = 147456, L_Q = 163840 - 320;


constexpr int RD = 4;
#define ATT_DMA_TILE(tt, kb_, vb_, stride_, w_) do { LAS unsigned char* d_ = ring + ((tt) % RD) * 2 * SLOT; const long ro_ = (long)(tt) * 64 * (stride_); \
    dma_slot(d_, (kb_) + ro_, (vb_) + ro_, (stride_), (w_), lane); dma_slot(d_ + SLOT, (kb_) + ro_ + 32 * (stride_), (vb_) + ro_ + 32 * (stride_), (stride_), (w_), lane); } while (0)
#define ATT_WAIT_NEXT(t, NTL_) do { const int last_ = ((t) + RD - 1 < (NTL_) - 1) ? (t) + RD - 1 : (NTL_) - 1; const int fly_ = last_ - ((t) + 1); \
    if (fly_ >= 2) asm volatile("s_waitcnt vmcnt(4)" ::: "memory"); else if (fly_ == 1) asm volatile("s_waitcnt vmcnt(2)" ::: "memory"); else asm volatile("s_waitcnt vmcnt(0)" ::: "memory"); \
    asm volatile("s_waitcnt lgkmcnt(0)" ::: "memory"); __builtin_amdgcn_s_barrier(); } while (0)
__device__ __forceinline__ void unitA(const Ctx& c, int b, int h, int qb) {
    int lane = c.lane; asm volatile("" : "+v"(lane));
    const int r32 = lane & 31, hi = lane >> 5, w = c.wave;
    LAS unsigned char* ring = c.lds + L_RING; LAS float* cumL = (LAS float*)(c.lds + L_CUM); LAS float* wsf = (LAS float*)(c.lds + L_WSF + w * 256);
    const int q0 = qb * 256, qabs = q0 + 32 * w + r32, NTL = 4 * (qb + 1);
    const bf16* QKVA = B_QKVA(c); const long stride = 1536 * 2;
    const char* kb = (const char*)(QKVA + (size_t)(b * S) * 1536 + 512 + h * 64); const char* vb = kb + 1024;
    const float* cum = B_CUM(c) + (size_t)(b * 8 + h) * S;
    for (int s = c.tid; s < q0 + 256; s += NT) cumL[s] = cum[s];
    bf16x8 qr[4];
#pragma unroll
    for (int d0 = 0; d0 < 4; ++d0) qr[d0] = *(const bf16x8*)(QKVA + (size_t)(b * S + qabs) * 1536 + h * 64 + d0 * 16 + hi * 8);
    const float cq = cum[qabs];
    St s; st_init(s); s.mref = REL_REF0;
    const int voff = ((lane >> 4) & 1) * 32 + (lane & 3) * 8 + (4 * hi + ((lane & 15) >> 2)) * 64;
    int T0;
    { const int tl = lane < NTL ? lane : NTL - 1; const int ke = 64 * tl + 63 < q0 ? 64 * tl + 63 : q0;
      const float bnd = cum[q0] - cum[ke];
      const unsigned long long ok = __ballot(bnd >= -(40.0f + 2.0f * QK_BOUND));
      T0 = __builtin_amdgcn_readfirstlane((int)__builtin_ctzll(ok)); }
    asm volatile("s_waitcnt vmcnt(0)" ::: "memory");
#pragma unroll
    for (int tt = 0; tt < RD - 1; ++tt) if (T0 + tt < NTL) ATT_DMA_TILE(T0 + tt, kb, vb, stride, w);
    ATT_WAIT_NEXT(T0 - 1, NTL);
    for (int t = T0; t < NTL; ++t) {
        LAS unsigned char* cur = ring + (t % RD) * 2 * SLOT;
        if (t + RD - 1 < NTL) ATT_DMA_TILE(t + RD - 1, kb, vb, stride, w);
        if (64 * t <= q0 + 32 * w + 31) {
            f32x16 p0, p1; const float cqm = cq - s.mref;
#pragma unroll
            for (int g = 0; g < 4; ++g) { const f32x4 c0 = *(LAS const f32x4*)(cumL + 64 * t + 8 * g + 4 * hi), c1 = *(LAS const f32x4*)(cumL + 64 * t + 32 + 8 * g + 4 * hi);
                const f32x4 e0 = cqm - c0, e1 = cqm - c1;
                p0[4 * g] = e0.x; p0[4 * g + 1] = e0.y; p0[4 * g + 2] = e0.z; p0[4 * g + 3] = e0.w;
                p1[4 * g] = e1.x; p1[4 * g + 1] = e1.y; p1[4 * g + 2] = e1.z; p1[4 * g + 3] = e1.w; }
            qk_slot(p0, cur, qr, r32, hi); qk_slot(p1, cur + SLOT, qr, r32, hi);
            if (64 * t + 63 > q0 + 32 * w) {
#pragma unroll
                for (int r = 0; r < 16; ++r) { const int k = 64 * t + crow(r, hi); if (k > qabs) p0[r] = -INFINITY; if (k + 32 > qabs) p1[r] = -INFINITY; }
            }
            sm_rescale_rel(s, fmaxf(max16(p0), max16(p1)), p0, p1, wsf, r32, hi);
            sm_exp_rel(s, p0); sm_exp_rel(s, p1);
            pv_slot(s.o0, s.o1, p0, cur, voff); pv_slot(s.o0, s.o1, p1, cur + SLOT, voff);
        }
        ATT_WAIT_NEXT(t, NTL);
    }
    const int rowb = b * S + q0 + 32 * w;
    (void)finish(s, wsf, c.lds + L_STG + w * 4096, B_ZY(c) + h * 64, [rowb](int q) { return rowb + q; }, lane, r32, hi, c.dry);
    __syncthreads();
}

__device__ __forceinline__ void unitB2(const Ctx& c, int b, int jj) {
    int lane = c.lane; asm volatile("" : "+v"(lane));
    const int r32 = lane & 31, hi = lane >> 5, h = c.wave;
    LAS unsigned char* ring = c.lds + L_RING;
    LAS float* wsf0 = (LAS float*)(c.lds + L_WSF + h * 512); LAS float* wsf1 = wsf0 + 64;
    const int t0 = 64 * jj, NTL = jj + 1, qa0 = t0 + r32, qa1 = t0 + 32 + r32;
    const long stride = 128 * 2;
    const char* kb = (const char*)(B_KVB(c) + (size_t)(b * S) * 128); const char* vb = kb + 128;
#define B_DMA_SEQ(i_) do { const int tt_ = NTL - 1 - (i_); LAS unsigned char* d_ = ring + ((i_) % RD) * 2 * SLOT; const long ro_ = (long)tt_ * 64 * stride; \
        dma_slot(d_, kb + ro_, vb + ro_, stride, h, lane); dma_slot(d_ + SLOT, kb + ro_ + 32 * stride, vb + ro_ + 32 * stride, stride, h, lane); } while (0)
#pragma unroll
    for (int ii = 0; ii < RD - 1; ++ii) if (ii < NTL) B_DMA_SEQ(ii);
    bf16x8 qr0[4], qr1[4];
    LAS unsigned* mskL = (LAS unsigned*)(c.lds + L_RING + 81920);
    { const u32x4* mg = (const u32x4*)(B_MASK(c) + (size_t)(b * S + t0) * 64); const u32x4 ma = mg[c.tid], mb = mg[512 + c.tid];
#pragma unroll
      for (int g = 0; g < 2; ++g) { const int qrow = b * S + t0 + 32 * g + r32;
        const f32x4 sq = *(const f32x4*)(B_SSQC(c) + (size_t)qrow * 8); u32x4 v[4];
#pragma unroll
        for (int d0 = 0; d0 < 4; ++d0) v[d0] = *(const u32x4*)(B_QB(c) + (size_t)qrow * 512 + h * 64 + d0 * 16 + hi * 8);
        const float rs = __builtin_amdgcn_rsqf(((sq.x + sq.y) + (sq.z + sq.w)) * (1.0f / 256) + EPS);
#pragma unroll
        for (int d0 = 0; d0 < 4; ++d0) { u32x4 o;
            o.x = pk2(bflo(v[d0].x) * rs, bfhi(v[d0].x) * rs); o.y = pk2(bflo(v[d0].y) * rs, bfhi(v[d0].y) * rs); o.z = pk2(bflo(v[d0].z) * rs, bfhi(v[d0].z) * rs); o.w = pk2(bflo(v[d0].w) * rs, bfhi(v[d0].w) * rs);
            if (g == 0) qr0[d0] = __builtin_bit_cast(bf16x8, o); else qr1[d0] = __builtin_bit_cast(bf16x8, o); } }
      *(LAS u32x4*)(mskL + c.tid * 4) = ma; *(LAS u32x4*)(mskL + 2048 + c.tid * 4) = mb; }
    const float slope2 = exp2f(-(float)(h + 1)) * LOG2E;
    LAS const unsigned* mrow0 = mskL + r32 * 64; LAS const unsigned* mrow1 = mskL + (32 + r32) * 64;
    St s0, s1; st_init(s0); st_init(s1); s0.mref = REL_REF0; s1.mref = REL_REF0;
    const int voff = ((lane >> 4) & 1) * 32 + (lane & 3) * 8 + (4 * hi + ((lane & 15) >> 2)) * 64;
    asm volatile("s_waitcnt vmcnt(0)" ::: "memory");
    asm volatile("s_waitcnt lgkmcnt(0)" ::: "memory"); __builtin_amdgcn_s_barrier();
    bool done = false;
    for (int i = 0; i < NTL; ++i) {
        const int t = NTL - 1 - i;
        LAS unsigned char* cur = ring + (i % RD) * 2 * SLOT;
        if (i + RD - 1 < NTL) B_DMA_SEQ(i + RD - 1);
        if (!done) {
            const float ub0 = QK_BOUND - slope2 * (float)(qa0 - (64 * t + 63)), ub1 = QK_BOUND - slope2 * (float)(qa1 - (64 * t + 63));
            done = __all(ub0 < s0.mref - (40.0f + THR) && ub1 < s1.mref - (40.0f + THR));
        }
        if (!done) {
        const u32x2 mw0 = *(LAS const u32x2*)(mrow0 + 2 * t), mw1 = *(LAS const u32x2*)(mrow1 + 2 * t);
        const unsigned m00 = mw0.x >> (4 * hi), m01 = mw0.y >> (4 * hi), m10 = mw1.x >> (4 * hi), m11 = mw1.y >> (4 * hi);
        const float base0 = slope2 * (float)(64 * t + 4 * hi - qa0) - s0.mref, base1 = slope2 * (float)(64 * t + 4 * hi - qa1) - s1.mref;
        f32x16 p00, p01, p10, p11;
#pragma unroll
        for (int r = 0; r < 16; ++r) { const float kk = (float)((r & 3) + 8 * (r >> 2));
            p00[r] = fmaf(slope2, kk, base0); p01[r] = fmaf(slope2, kk + 32.f, base0); p10[r] = fmaf(slope2, kk, base1); p11[r] = fmaf(slope2, kk + 32.f, base1); }
#pragma unroll
        for (int d0 = 0; d0 < 4; ++d0) {
            const bf16x8 k0 = *(LAS const bf16x8*)(cur + (2 * d0 + hi) * 512 + r32 * 16), k1 = *(LAS const bf16x8*)(cur + SLOT + (2 * d0 + hi) * 512 + r32 * 16);
            p00 = __builtin_amdgcn_mfma_f32_32x32x16_bf16(k0, qr0[d0], p00, 0, 0, 0); p10 = __builtin_amdgcn_mfma_f32_32x32x16_bf16(k0, qr1[d0], p10, 0, 0, 0);
            p01 = __builtin_amdgcn_mfma_f32_32x32x16_bf16(k1, qr0[d0], p01, 0, 0, 0); p11 = __builtin_amdgcn_mfma_f32_32x32x16_bf16(k1, qr1[d0], p11, 0, 0, 0); }
#pragma unroll
        for (int r = 0; r < 16; ++r) { const int pos = (r & 3) + 8 * (r >> 2);
#define B_MSK(p_, m_) do { const unsigned t_ = (unsigned)__builtin_amdgcn_sbfe((int)(m_), pos, 1); p_[r] = __uint_as_float((__float_as_uint(p_[r]) & t_) | (0xFF800000u & ~t_)); } while (0)
            B_MSK(p00, m00); B_MSK(p01, m01); B_MSK(p10, m10); B_MSK(p11, m11); }
#undef B_MSK
        sm_rescale_rel(s0, fmaxf(max16(p00), max16(p01)), p00, p01, wsf0, r32, hi); sm_rescale_rel(s1, fmaxf(max16(p10), max16(p11)), p10, p11, wsf1, r32, hi);
        sm_exp_rel(s0, p00); sm_exp_rel(s1, p10); sm_exp_rel(s0, p01); sm_exp_rel(s1, p11);
        {
            const bf16x8 a00 = pack_p(p00, 0), a01 = pack_p(p00, 8), a10 = pack_p(p10, 0), a11 = pack_p(p10, 8);
            LAS const unsigned char* vp = cur + SLOT_V + voff;
            bf16x8 vf = vfrag(vp);        s0.o0 = __builtin_amdgcn_mfma_f32_32x32x16_bf16(a00, vf, s0.o0, 0, 0, 0); s1.o0 = __builtin_amdgcn_mfma_f32_32x32x16_bf16(a10, vf, s1.o0, 0, 0, 0);
            vf = vfrag(vp + 2048);        s0.o1 = __builtin_amdgcn_mfma_f32_32x32x16_bf16(a00, vf, s0.o1, 0, 0, 0); s1.o1 = __builtin_amdgcn_mfma_f32_32x32x16_bf16(a10, vf, s1.o1, 0, 0, 0);
            vf = vfrag(vp + 1024);        s0.o0 = __builtin_amdgcn_mfma_f32_32x32x16_bf16(a01, vf, s0.o0, 0, 0, 0); s1.o0 = __builtin_amdgcn_mfma_f32_32x32x16_bf16(a11, vf, s1.o0, 0, 0, 0);
            vf = vfrag(vp + 3072);        s0.o1 = __builtin_amdgcn_mfma_f32_32x32x16_bf16(a01, vf, s0.o1, 0, 0, 0); s1.o1 = __builtin_amdgcn_mfma_f32_32x32x16_bf16(a11, vf, s1.o1, 0, 0, 0);
            const bf16x8 b00 = pack_p(p01, 0), b01 = pack_p(p01, 8), b10 = pack_p(p11, 0), b11 = pack_p(p11, 8);
            vp += SLOT;
            vf = vfrag(vp);               s0.o0 = __builtin_amdgcn_mfma_f32_32x32x16_bf16(b00, vf, s0.o0, 0, 0, 0); s1.o0 = __builtin_amdgcn_mfma_f32_32x32x16_bf16(b10, vf, s1.o0, 0, 0, 0);
            vf = vfrag(vp + 2048);        s0.o1 = __builtin_amdgcn_mfma_f32_32x32x16_bf16(b00, vf, s0.o1, 0, 0, 0); s1.o1 = __builtin_amdgcn_mfma_f32_32x32x16_bf16(b10, vf, s1.o1, 0, 0, 0);
            vf = vfrag(vp + 1024);        s0.o0 = __builtin_amdgcn_mfma_f32_32x32x16_bf16(b01, vf, s0.o0, 0, 0, 0); s1.o0 = __builtin_amdgcn_mfma_f32_32x32x16_bf16(b11, vf, s1.o0, 0, 0, 0);
            vf = vfrag(vp + 3072);        s0.o1 = __builtin_amdgcn_mfma_f32_32x32x16_bf16(b01, vf, s0.o1, 0, 0, 0); s1.o1 = __builtin_amdgcn_mfma_f32_32x32x16_bf16(b11, vf, s1.o1, 0, 0, 0);
        }
        }
        ATT_WAIT_NEXT(i, NTL);
    }
#undef B_DMA_SEQ
    const int rowb0 = b * S + t0, rowb1 = rowb0 + 32;
    (void)finish(s0, wsf0, c.lds + L_STG + h * 4096, B_ZY(c) + 512 + h * 64, [rowb0](int q) { return rowb0 + q; }, lane, r32, hi, c.dry);
    asm volatile("s_waitcnt lgkmcnt(0)" ::: "memory");
    (void)finish(s1, wsf1, c.lds + L_STG + h * 4096, B_ZY(c) + 512 + h * 64, [rowb1](int q) { return rowb1 + q; }, lane, r32, hi, c.dry);
    __syncthreads();
}

struct CPre { bf16x8 qr[4]; u32x4 zv[4]; };
struct CGeo { int g, L, lgL, lgD, b, r0; float slope2; };
__device__ __forceinline__ CGeo c_geo(int blk, int hd) { CGeo q; q.g = hd >> 2; const int dil = q.g == 0 ? 1 : (q.g == 1 ? 4 : 16); q.L = S / dil; q.lgL = q.g == 0 ? 11 : (q.g == 1 ? 9 : 7); q.lgD = q.g == 0 ? 0 : (q.g == 1 ? 2 : 4);
    q.b = blk >> 3; q.r0 = (blk & 7) * 256; q.slope2 = exp2f(-8.0f * (float)(hd + 1) / 12.0f) * LOG2E * (float)dil; return q; }
__device__ __forceinline__ void unitC_issue(const Ctx& c, int blk, int hd, CPre& P, int lane) {
    const int r32 = lane & 31, hi = lane >> 5, w = c.wave; const CGeo G = c_geo(blk, hd);
    LAS unsigned char* ring = c.lds + L_RING;
    const bf16* QKVC = B_QKVC(c); const long stride = 2304 * 2;
    const char* kb = (const char*)(QKVC + (size_t)(G.b * S) * 2304 + 768 + hd * 64); const char* vb = kb + 1536;
#pragma unroll
    for (int i = 0; i < 12; ++i) { int rr = G.r0 - 128 + 32 * i; if (rr < 0) rr = 0; dma_slot(ring + i * SLOT, kb + (long)rr * stride, vb + (long)rr * stride, stride, w, lane); }
    const int rq = G.r0 + 32 * w + r32;
#pragma unroll
    for (int d0 = 0; d0 < 4; ++d0) P.qr[d0] = *(const bf16x8*)(QKVC + (size_t)(G.b * S + rq) * 2304 + hd * 64 + d0 * 16 + hi * 8);
    const int rbase = G.r0 + 32 * w, bS = G.b * S;
#pragma unroll
    for (int i = 0; i < 4; ++i) { const int rr = rbase + i * 8 + (lane >> 3); const int row = bS + (rr >> G.lgL) + ((rr & (G.L - 1)) << G.lgD);
        P.zv[i] = *(const u32x4*)(B_ZY(c) + 1024 + hd * 64 + (size_t)row * 1792 + (lane & 7) * 8); }
}
template <class Mid>
__device__ __forceinline__ void unitC_run(const Ctx& c, int blk, int hd, CPre& P, int lane, Mid mid) {
    const int r32 = lane & 31, hi = lane >> 5, w = c.wave; const CGeo G = c_geo(blk, hd);
    LAS unsigned char* ring = c.lds + L_RING; LAS float* wsf = (LAS float*)(c.lds + L_WSF + w * 256);
    const int lgL = G.lgL, lgD = G.lgD, L = G.L, r0 = G.r0;
    const int rq = r0 + 32 * w + r32; const float slope2 = G.slope2;
    const int cs = (rq >> lgL) << lgL;
    St s; st_init(s); s.mref = REL_REF0;
    const int voff = ((lane >> 4) & 1) * 32 + (lane & 3) * 8 + (4 * hi + ((lane & 15) >> 2)) * 64;
#pragma unroll 1
    for (int i = 0; i < 5; ++i) {
        LAS unsigned char* cur = ring + (w + i) * SLOT;
        const int rk0 = r0 - 128 + 32 * (w + i) + 4 * hi;
        f32x16 p;
        const int d0 = rk0 - rq; const float b0 = fmaf(slope2, (float)d0, -s.mref);
#pragma unroll
        for (int r = 0; r < 16; ++r) p[r] = fmaf(slope2, (float)((r & 3) + 8 * (r >> 2)), b0);
        qk_slot(p, cur, P.qr, r32, hi);
        unsigned vm;
        { const int hb = -d0, lo = (rq - 128 > cs ? rq - 128 : cs) - rk0, loc = lo < 0 ? 0 : lo, hic = hb > 31 ? 31 : hb;
          vm = ((2u << (hic & 31)) - 1u) & ~((1u << (loc & 31)) - 1u); if (hb < 0 || lo > 31 || hic < loc) vm = 0u; }
#pragma unroll
        for (int r = 0; r < 16; ++r) { const unsigned t_ = (unsigned)__builtin_amdgcn_sbfe((int)vm, (r & 3) + 8 * (r >> 2), 1); p[r] = __uint_as_float((__float_as_uint(p[r]) & t_) | (0xFF800000u & ~t_)); }
        sm_rescale_rel(s, max16(p), p, wsf, r32, hi);
        sm_exp_rel(s, p);
        pv_slot(s.o0, s.o1, p, cur, voff);
    }
    u32x4 zc[4];
#pragma unroll
    for (int i = 0; i < 4; ++i) zc[i] = P.zv[i];
    mid();
    const int rbase = r0 + 32 * w, bS = G.b * S;
    const float lse = finish(s, wsf, c.lds + L_STG + w * 4096, B_ZY(c) + 1024 + hd * 64,
                             [=](int q) { const int rr = rbase + q; return bS + (rr >> lgL) + ((rr & (L - 1)) << lgD); }, lane, r32, hi, 0, zc);
    if (hi == 0) { const int rr = rbase + r32; B_LSE(c)[(size_t)(bS + (rr >> lgL) + ((rr & (L - 1)) << lgD)) * 12 + hd] = lse; }
}
__device__ __forceinline__ void unitCfix(const Ctx& c, int blk) {
    int lane = c.lane; asm volatile("" : "+v"(lane));
#pragma unroll 1
    for (int st = 0; st < 8; ++st) {
        const int r0 = blk * 256 + c.wave * 32 + st * 4;
        u32x4 v[6]; float l0[6], l1[6], l2[6]; u32x4* pp[6]; int gsel[6];
#pragma unroll
        for (int k = 0; k < 6; ++k) { const int ck = lane + 64 * k, row = r0 + ck / 96, q = ck % 96, hd = q >> 3, j = hd & 3;
            pp[k] = (u32x4*)(B_ZY(c) + (size_t)row * 1792 + 1024) + q; v[k] = *pp[k]; gsel[k] = hd >> 2;
            const float* ls = B_LSE(c) + (size_t)row * 12 + j; l0[k] = ls[0]; l1[k] = ls[4]; l2[k] = ls[8]; }
#pragma unroll
        for (int k = 0; k < 6; ++k) {
            const float lm = fmaxf(l0[k], fmaxf(l1[k], l2[k])), e0 = fexp2(l0[k] - lm), e1 = fexp2(l1[k] - lm), e2 = fexp2(l2[k] - lm);
            const float a = (gsel[k] == 0 ? e0 : (gsel[k] == 1 ? e1 : e2)) * __builtin_amdgcn_rcpf(e0 + e1 + e2);
            u32x4 q = v[k];
            q.x = pk2(bflo(q.x) * a, bfhi(q.x) * a); q.y = pk2(bflo(q.y) * a, bfhi(q.y) * a); q.z = pk2(bflo(q.z) * a, bfhi(q.z) * a); q.w = pk2(bflo(q.w) * a, bfhi(q.w) * a);
            *pp[k] = q; }
    }
}
__device__ __forceinline__ void unitKV(const Ctx& c, int blk) {
    const int r32 = c.lane & 31, hi = c.lane >> 5, row = blk * 256 + c.wave * 32 + r32;
    const bf16* ap = B_CKV(c) + (size_t)row * 128 + hi * 8; const bf16* W = B_WKVT(c);
    bf16x8 a[8];
#pragma unroll
    for (int k = 0; k < 8; ++k) a[k] = *(const bf16x8*)(ap + 16 * k);
    const f32x4 q = *(const f32x4*)(B_SSQC(c) + (size_t)row * 8 + 4); const float rs = 1.0f / sqrtf(((q.x + q.y) + (q.z + q.w)) * (1.0f / 128) + EPS);
#pragma unroll 1
    for (int nt = 0; nt < 4; ++nt) { f32x16 acc = {}; const bf16* bp = W + (size_t)(nt * 32 + r32) * 128 + hi * 8;
        bf16x8 w[8];
#pragma unroll
        for (int k = 0; k < 8; ++k) w[k] = *(const bf16x8*)(bp + 16 * k);
        asm volatile("" : "+v"(w[0]), "+v"(w[1]), "+v"(w[2]), "+v"(w[3]), "+v"(w[4]), "+v"(w[5]), "+v"(w[6]), "+v"(w[7]));
#pragma unroll
        for (int k = 0; k < 8; ++k) acc = __builtin_amdgcn_mfma_f32_32x32x16_bf16(w[k], a[k], acc, 0, 0, 0);
#pragma unroll
        for (int g = 0; g < 4; ++g) st_bf4(B_KVB(c) + (size_t)row * 128 + nt * 32 + 8 * g + 4 * hi, (f32x4){acc[4 * g], acc[4 * g + 1], acc[4 * g + 2], acc[4 * g + 3]} * rs); }
}
__device__ __forceinline__ void unitCum(const Ctx& c, int b) {
    const int h = c.wave, lane = c.lane; const float bf = P_BF(c)[c.layer * 8 + h];
    const float* wf = B_WF(c) + (size_t)(b * S + 32 * lane) * 16 + 8 + h; float v[32]; float run = 0.f;
#pragma unroll
    for (int i = 0; i < 32; ++i) { run += logsigmoidf_(wf[i * 16] + bf) * LOG2E; v[i] = run; }
    float incl = run;
#pragma unroll
    for (int o = 1; o < 64; o <<= 1) { const float t = shup(incl, o, lane); if (lane >= o) incl += t; }
    const float excl = incl - run; float* dst = B_CUM(c) + (size_t)(b * 8 + h) * S + 32 * lane;
#pragma unroll
    for (int i = 0; i < 32; i += 4) *(f32x4*)(dst + i) = (f32x4){v[i] + excl, v[i + 1] + excl, v[i + 2] + excl, v[i + 3] + excl};
}

__device__ __forceinline__ unsigned sortable(float sc) { sc += 0.0f; const unsigned bits = __builtin_bit_cast(unsigned, sc); return bits ^ ((unsigned)((int)bits >> 31) | 0x80000000u); }
__device__ __forceinline__ unsigned wave_sum_u(unsigned v) {
    v += (unsigned)__builtin_amdgcn_update_dpp(0, (int)v, 0x111, 0xf, 0xf, true);
    v += (unsigned)__builtin_amdgcn_update_dpp(0, (int)v, 0x112, 0xf, 0xf, true);
    v += (unsigned)__builtin_amdgcn_update_dpp(0, (int)v, 0x114, 0xf, 0xf, true);
    v += (unsigned)__builtin_amdgcn_update_dpp(0, (int)v, 0x118, 0xf, 0xf, true);
    return (unsigned)__builtin_amdgcn_readlane((int)v, 15) + (unsigned)__builtin_amdgcn_readlane((int)v, 31) + (unsigned)__builtin_amdgcn_readlane((int)v, 47) + (unsigned)__builtin_amdgcn_readlane((int)v, 63);
}
__device__ __forceinline__ unsigned half_sum16(unsigned v, int hi) {
    v += (unsigned)__builtin_amdgcn_update_dpp(0, (int)v, 0x111, 0xf, 0xf, true);
    v += (unsigned)__builtin_amdgcn_update_dpp(0, (int)v, 0x112, 0xf, 0xf, true);
    v += (unsigned)__builtin_amdgcn_update_dpp(0, (int)v, 0x114, 0xf, 0xf, true);
    v += (unsigned)__builtin_amdgcn_update_dpp(0, (int)v, 0x118, 0xf, 0xf, true);
    const unsigned lo = (unsigned)__builtin_amdgcn_readlane((int)v, 15) + (unsigned)__builtin_amdgcn_readlane((int)v, 31);
    const unsigned hs = (unsigned)__builtin_amdgcn_readlane((int)v, 47) + (unsigned)__builtin_amdgcn_readlane((int)v, 63);
    return hi ? hs : lo;
}
__device__ __forceinline__ void bit_tr_s16(unsigned (&a)[64], const int o) {
#pragma unroll
    for (int k = 0; k < 16; ++k) { const unsigned x = a[o + k], y = a[o + k + 16]; a[o + k] = __builtin_amdgcn_perm(x, y, 0x07060302u); a[o + k + 16] = __builtin_amdgcn_perm(x, y, 0x05040100u); }
}
__device__ __forceinline__ void bit_tr16(unsigned (&a)[64], const int o) {
#pragma unroll
    for (int k = 0; k < 8; ++k) { const unsigned x = a[o + k], y = a[o + k + 8]; a[o + k] = __builtin_amdgcn_perm(x, y, 0x07030501u); a[o + k + 8] = __builtin_amdgcn_perm(x, y, 0x06020400u); }
#define TR_ST(j_, m_) _Pragma("unroll") for (int k = 0; k < 16; ++k) if (!(k & j_)) { const unsigned x = a[o + k], y = a[o + k + j_]; \
        a[o + k] = (x & ~m_) | ((y >> j_) & m_); a[o + k + j_] = (y & ~(m_ << j_)) | ((x << j_) & (m_ << j_)); }
    TR_ST(4, 0x0F0F0F0Fu) TR_ST(2, 0x33333333u) TR_ST(1, 0x55555555u)
#undef TR_ST
}
__device__ __forceinline__ void sel_issue(const Ctx& c, int b, int j, int lane) {
    const int r32 = lane & 31, hi = lane >> 5, w = c.wave, ntile = j + 1;
    LAS unsigned char* kl = c.lds; const bf16* KI = B_KI(c) + (size_t)(b * S) * 32;
    for (int k = w; k < ntile; k += 8) {
        const char* sp = (const char*)(KI + (size_t)(32 * k + r32) * 32 + 8 * hi);
        glds16(sp, (unsigned)__builtin_amdgcn_readfirstlane((int)((unsigned)(uintptr_t)kl + k * 2048)));
        glds16(sp + 32, (unsigned)__builtin_amdgcn_readfirstlane((int)((unsigned)(uintptr_t)kl + k * 2048 + 1024)));
    }
    const char* qs = (const char*)(B_QI(c) + (size_t)(b * S + 32 * j) * 256) + w * 2048 + lane * 16;
    glds16(qs, (unsigned)__builtin_amdgcn_readfirstlane((int)((unsigned)(uintptr_t)kl + L_SQ + w * 2048)));
    glds16(qs + 1024, (unsigned)__builtin_amdgcn_readfirstlane((int)((unsigned)(uintptr_t)kl + L_SQ + w * 2048 + 1024)));
    if (w < 2) glds16((const char*)(B_WF(c) + (size_t)(b * S + 32 * j) * 16) + w * 1024 + lane * 16, (unsigned)__builtin_amdgcn_readfirstlane((int)((unsigned)(uintptr_t)kl + L_SW + w * 1024)));
}
template <class Mid>
__device__ __forceinline__ void unitSel(const Ctx& c, int b, int j, bool pre, Mid mid) {
    int lane = c.lane; asm volatile("" : "+v"(lane));
    const int r32 = lane & 31, hi = lane >> 5, w = c.wave, ntile = j + 1;
    LAS unsigned char* kl = c.lds;
    if (!pre) sel_issue(c, b, j, lane);
    const int tq = 32 * j + 4 * w;
    asm volatile("s_waitcnt vmcnt(0)" ::: "memory"); __syncthreads();
    bf16x8 aop[2];
    { const int a = r32 & 3, hb = (r32 >> 2) & 1, cc = r32 >> 3, h = a + 4 * (cc & 1), qi = hb + 2 * (cc >> 1);
      LAS const bf16* qp = (LAS const bf16*)(kl + L_SQ) + (4 * w + qi) * 256 + h * 32 + 8 * hi;
      aop[0] = *(LAS const bf16x8*)qp; aop[1] = *(LAS const bf16x8*)(qp + 16); }
    f32x2v wAB[8];
    { LAS const f32x4* pa = (LAS const f32x4*)(kl + L_SW + (4 * w + hi) * 64); LAS const f32x4* pb = (LAS const f32x4*)(kl + L_SW + (4 * w + hi + 2) * 64);
      const f32x4 a0 = pa[0], a1 = pa[1], b0 = pb[0], b1 = pb[1];
      wAB[0] = (f32x2v){a0.x, b0.x}; wAB[1] = (f32x2v){a0.y, b0.y}; wAB[2] = (f32x2v){a0.z, b0.z}; wAB[3] = (f32x2v){a0.w, b0.w};
      wAB[4] = (f32x2v){a1.x, b1.x}; wAB[5] = (f32x2v){a1.y, b1.y}; wAB[6] = (f32x2v){a1.z, b1.z}; wAB[7] = (f32x2v){a1.w, b1.w}; }
    unsigned uA[64], uB[64];
    const int tA = tq + hi, tB = tq + hi + 2;
#define SEL_MF(k_, d_) do { const bf16x8 b0_ = *(LAS const bf16x8*)(kl + (k_) * 2048 + hi * 512 + r32 * 16), b1_ = *(LAS const bf16x8*)(kl + (k_) * 2048 + 1024 + hi * 512 + r32 * 16); \
        d_ = f32x16{}; d_ = __builtin_amdgcn_mfma_f32_32x32x16_bf16(aop[0], b0_, d_, 0, 0, 0); d_ = __builtin_amdgcn_mfma_f32_32x32x16_bf16(aop[1], b1_, d_, 0, 0, 0); } while (0)
#define SEL_POST(k_, d_, msk_) do { f32x2v sAB = {0.f, 0.f}, sAB1 = {0.f, 0.f};                      \
        _Pragma("unroll") for (int r = 0; r < 8; ++r) { const int ia = __float_as_int(d_[r]), ib = __float_as_int(d_[8 + r]);     \
            const f32x2v t = {__int_as_float(ia > 0 ? ia : 0), __int_as_float(ib > 0 ? ib : 0)}; \
            if (r & 1) sAB1 = wAB[r] * t + sAB1; else sAB = wAB[r] * t + sAB; } \
        sAB = sAB + sAB1; const int key = 32 * (k_) + r32; \
        if (msk_) { uA[k_] = key <= tA ? sortable(sAB.x) : 0u; uB[k_] = key <= tB ? sortable(sAB.y) : 0u; } else { uA[k_] = sortable(sAB.x); uB[k_] = sortable(sAB.y); } } while (0)
    f32x16 dq[2];
    SEL_MF(0, dq[0]);
#pragma unroll
    for (int k = 0; k < 64; ++k) {
        uA[k] = 0u; uB[k] = 0u;
        if (k + 1 < ntile) { if (k + 1 < 64) SEL_MF(k + 1, dq[(k + 1) & 1]); SEL_POST(k, dq[k & 1], false); }
        else if (k < ntile) { SEL_POST(k, dq[k & 1], true); }
        __builtin_amdgcn_sched_barrier(0);
    }
#undef SEL_MF
#undef SEL_POST
    mid();
    bit_tr_s16(uA, 0); bit_tr_s16(uB, 0); bit_tr16(uA, 0); bit_tr16(uB, 0);
    if (ntile > 32) { bit_tr_s16(uA, 32); bit_tr_s16(uB, 32); bit_tr16(uA, 32); bit_tr16(uB, 32); }
    unsigned alA0 = ~0u, alA1 = ~0u, alB0 = ~0u, alB1 = ~0u, gsA0 = 0u, gsA1 = 0u, gsB0 = 0u, gsB1 = 0u, gcA = 0u, gcB = 0u;
    if (j < 8) {
        alA0 = 0u; alB0 = 0u; alA1 = 0u; alB1 = 0u; bit_tr16(uA, 16); bit_tr16(uB, 16);
#pragma unroll
        for (int p = 0; p < 32; ++p) { alA0 |= uA[p]; alB0 |= uB[p]; }
    } else {
        bool doneA = false, doneB = false;
#pragma unroll
        for (int bit = 31; bit >= 0; --bit) {
            if (bit == 15) { bit_tr16(uA, 16); bit_tr16(uB, 16); if (ntile > 32) { bit_tr16(uA, 48); bit_tr16(uB, 48); } }
            const unsigned tA0 = alA0 & uA[31 - bit], tA1 = alA1 & uA[63 - bit], tB0 = alB0 & uB[31 - bit], tB1 = alB1 & uB[63 - bit];
            const unsigned cA = (unsigned)__popc(tA0) + (unsigned)__popc(tA1) + gcA, cB = (unsigned)__popc(tB0) + (unsigned)__popc(tB1) + gcB;
            const unsigned cnt = half_sum16(cA | (cB << 16), hi);
            const unsigned nA = cnt & 0xffffu, nB = cnt >> 16;
            const bool accA = nA >= 256u, accB = nB >= 256u;
            const unsigned rjA = accA ? 0u : ~0u, rjB = accB ? 0u : ~0u;
            alA0 &= uA[31 - bit] ^ rjA; alA1 &= uA[63 - bit] ^ rjA; gsA0 |= tA0 & rjA; gsA1 |= tA1 & rjA; gcA = accA ? gcA : cA;
            alB0 &= uB[31 - bit] ^ rjB; alB1 &= uB[63 - bit] ^ rjB; gsB0 |= tB0 & rjB; gsB1 |= tB1 & rjB; gcB = accB ? gcB : cB;
            doneA = doneA || nA == 256u; doneB = doneB || nB == 256u;
            if (__all(doneA && doneB)) break;
        }
    }
    const unsigned mA0 = gsA0 | alA0, mA1 = gsA1 | alA1, mB0 = gsB0 | alB0, mB1 = gsB1 | alB1;
    unsigned* mbase = B_MASK(c) + (size_t)(b * S + tq) * 64 + lane;
    const unsigned nsel = half_sum16(((unsigned)__popc(mA0) + (unsigned)__popc(mA1)) | (((unsigned)__popc(mB0) + (unsigned)__popc(mB1)) << 16), hi);
    const bool ties = __any(j >= 8 && ((nsel & 0xffffu) > 256u || (nsel >> 16) > 256u));
    unsigned M0 = 0u, M1 = 0u, M2 = 0u, M3 = 0u, G0 = 0u, G1 = 0u, G2 = 0u, G3 = 0u;
#define SEL_WL(k_) do { const unsigned bm = 0x80000000u >> ((k_) & 31); \
        const unsigned long long ga = __ballot((((k_) < 32 ? mA0 : mA1) & bm) != 0u), gb = __ballot((((k_) < 32 ? mB0 : mB1) & bm) != 0u); \
        asm("v_writelane_b32 %0, %1, %2" : "+v"(M0) : "s"((unsigned)ga), "n"(k_)); asm("v_writelane_b32 %0, %1, %2" : "+v"(M1) : "s"((unsigned)(ga >> 32)), "n"(k_)); \
        asm("v_writelane_b32 %0, %1, %2" : "+v"(M2) : "s"((unsigned)gb), "n"(k_)); asm("v_writelane_b32 %0, %1, %2" : "+v"(M3) : "s"((unsigned)(gb >> 32)), "n"(k_)); } while (0)
#define SEL_WG(k_) do { const unsigned bm = 0x80000000u >> ((k_) & 31); \
        const unsigned long long ta = __ballot((((k_) < 32 ? gsA0 : gsA1) & bm) != 0u), tb = __ballot((((k_) < 32 ? gsB0 : gsB1) & bm) != 0u); \
        asm("v_writelane_b32 %0, %1, %2" : "+v"(G0) : "s"((unsigned)ta), "n"(k_)); asm("v_writelane_b32 %0, %1, %2" : "+v"(G1) : "s"((unsigned)(ta >> 32)), "n"(k_)); \
        asm("v_writelane_b32 %0, %1, %2" : "+v"(G2) : "s"((unsigned)tb), "n"(k_)); asm("v_writelane_b32 %0, %1, %2" : "+v"(G3) : "s"((unsigned)(tb >> 32)), "n"(k_)); } while (0)
#define SEL_X16(F_, k0_) do { F_(k0_ + 0); F_(k0_ + 1); F_(k0_ + 2); F_(k0_ + 3); F_(k0_ + 4); F_(k0_ + 5); F_(k0_ + 6); F_(k0_ + 7); \
        F_(k0_ + 8); F_(k0_ + 9); F_(k0_ + 10); F_(k0_ + 11); F_(k0_ + 12); F_(k0_ + 13); F_(k0_ + 14); F_(k0_ + 15); } while (0)
    SEL_X16(SEL_WL, 0); if (16 < ntile) SEL_X16(SEL_WL, 16); if (32 < ntile) SEL_X16(SEL_WL, 32); if (48 < ntile) SEL_X16(SEL_WL, 48);
    if (!ties) { mbase[0] = M0; mbase[64] = M1; mbase[128] = M2; mbase[192] = M3; }
    else {
        SEL_X16(SEL_WG, 0); if (16 < ntile) SEL_X16(SEL_WG, 16); if (32 < ntile) SEL_X16(SEL_WG, 32); if (48 < ntile) SEL_X16(SEL_WG, 48);
#define SEL_FIX_STORE(M, G, qi) do { \
            unsigned m_ = M; const int nge = (int)wave_sum_u((unsigned)__popc(M)); \
            if (j >= 8 && nge > 256) { const unsigned eq = M & ~G; const int pc = __popc(eq); const int ngt = (int)wave_sum_u((unsigned)__popc(G)); \
                int incl = pc; _Pragma("unroll") for (int o = 1; o < 64; o <<= 1) { const int t_ = shupi(incl, o, lane); if (lane >= o) incl += t_; } \
                int keep = 256 - ngt - (incl - pc); keep = keep < 0 ? 0 : (keep > pc ? pc : keep); \
                unsigned kept = eq; while (__popc(kept) > keep) kept &= ~(0x80000000u >> __clz((int)kept)); \
                m_ = G | kept; } \
            mbase[(qi) * 64] = m_; } while (0)
        SEL_FIX_STORE(M0, G0, 0); SEL_FIX_STORE(M1, G1, 1); SEL_FIX_STORE(M2, G2, 2); SEL_FIX_STORE(M3, G3, 3);
#undef SEL_FIX_STORE
    }
#undef SEL_X16
#undef SEL_WG
#undef SEL_WL
    __syncthreads();
}
__device__ __forceinline__ void unitXQ(const Ctx& c, int grow0) {
    const unsigned long long* SSQ1 = (const unsigned long long*)(c.ws + WS_SSQ) + MALL;
#pragma unroll 1
    for (int r0 = 0; r0 < 32; r0 += 4) {
        u32x4 a[4], b[4]; unsigned long long q[4];
#pragma unroll
        for (int r = 0; r < 4; ++r) { const int row = grow0 + c.wave * 32 + r0 + r;
            const u32x4* xp = (const u32x4*)((const bf16*)(c.ws + WS_XB) + (size_t)row * D) + 2 * c.lane; a[r] = xp[0]; b[r] = xp[1]; q[r] = SSQ1[row]; }
        asm volatile("" : "+v"(a[0]), "+v"(a[1]), "+v"(a[2]), "+v"(a[3]), "+v"(b[0]), "+v"(b[1]), "+v"(b[2]), "+v"(b[3]), "+v"(q[0]), "+v"(q[1]), "+v"(q[2]), "+v"(q[3]));
#pragma unroll
        for (int r = 0; r < 4; ++r) { const int row = grow0 + c.wave * 32 + r0 + r;
            const float qs = __builtin_amdgcn_rsqf((float)q[r] * (1.0f / SSQ_SCALE) * (1.0f / D) + EPS) * XQ_SCALE; u32x4 o;
            o.x = pk4q(bflo(a[r].x) * qs, bfhi(a[r].x) * qs, bflo(a[r].y) * qs, bfhi(a[r].y) * qs); o.y = pk4q(bflo(a[r].z) * qs, bfhi(a[r].z) * qs, bflo(a[r].w) * qs, bfhi(a[r].w) * qs);
            o.z = pk4q(bflo(b[r].x) * qs, bfhi(b[r].x) * qs, bflo(b[r].y) * qs, bfhi(b[r].y) * qs); o.w = pk4q(bflo(b[r].z) * qs, bfhi(b[r].z) * qs, bflo(b[r].w) * qs, bfhi(b[r].w) * qs);
            *((u32x4*)(c.ws + WS_XQ + (size_t)row * 1024) + c.lane) = o; }
    }
}
#define RUN_QUEUE(NU, ...) do { LAS int* qw_ = (LAS int*)(c.lds + L_Q); int u = c.bid; \
    while (u < (NU)) { unsigned nx_ = 0u; if (c.tid == 0) nx_ = __hip_atomic_fetch_add(ctr, 1u, __ATOMIC_RELAXED, __HIP_MEMORY_SCOPE_AGENT) + (unsigned)c.G; \
        __VA_ARGS__; \
        if (c.tid == 0) *qw_ = (int)nx_; __syncthreads(); u = *qw_; __syncthreads(); } } while (0)
__device__ __forceinline__ void interval1(const Ctx& c, unsigned* ctr, int lc) {
    constexpr int NC = 12 * (TC / 256), NKV = TC / 256, NCU = CB, NS = 64 * CB;
    const int NXQ = (lc >= 1 && lc <= NCH) ? TC / 256 : 0;
    const int NFN = (lc == 2 * NCH - 1) ? (MALL - TC) / 256 : 0;
    const int N0 = NCU + NKV + NXQ + NFN + NS, NALL = N0 + NC;
    LAS int* qw = (LAS int*)(c.lds + L_Q); int u = c.bid; bool selpre = false;
    while (u < N0) { unsigned nx = 0u; if (c.tid == 0) nx = __hip_atomic_fetch_add(ctr, 1u, __ATOMIC_RELAXED, __HIP_MEMORY_SCOPE_AGENT) + (unsigned)c.G;
        if (u < NCU) unitCum(c, u); else if (u < NCU + NKV) unitKV(c, u - NCU);
        else if (u < NCU + NKV + NXQ) unitXQ(c, (lc - 1) * TC + (u - NCU - NKV) * 256);
        else if (u < NCU + NKV + NXQ + NFN) { const int g0_ = (u - NCU - NKV - NXQ) * 256; final_norm_rows(c, g0_, g0_ + 256, c.wave, NWAVES); }
        else { const int SEL0 = NCU + NKV + NXQ + NFN, r2 = u - SEL0; int un = 0;
            unitSel(c, r2 % CB, 63 - r2 / CB, selpre, [&]() { if (c.tid == 0) *qw = (int)nx; __syncthreads(); un = *qw; selpre = false;
                if (un >= SEL0 && un < N0) { const int rn = un - SEL0; sel_issue(c, rn % CB, 63 - rn / CB, c.lane); selpre = true; } });
            u = un; continue; }
        if (c.tid == 0) *qw = (int)nx; __syncthreads(); u = *qw; __syncthreads(); }
    int lane = c.lane; asm volatile("" : "+v"(lane));
    CPre PA, PB; bool have = false;
#define C_STEP(CUR, NXT) do { unsigned nx = 0u; if (c.tid == 0) nx = __hip_atomic_fetch_add(ctr, 1u, __ATOMIC_RELAXED, __HIP_MEMORY_SCOPE_AGENT) + (unsigned)c.G; \
        const int v_ = u - N0; if (!have) unitC_issue(c, v_ / 12, v_ % 12, CUR, lane); \
        __builtin_amdgcn_s_waitcnt(0x0F70); __syncthreads();              \
        int un_ = 0; \
        unitC_run(c, v_ / 12, v_ % 12, CUR, lane, [&]() { if (c.tid == 0) *qw = (int)nx; __syncthreads(); un_ = *qw; \
            if (un_ < NALL) { const int vn_ = un_ - N0; unitC_issue(c, vn_ / 12, vn_ % 12, NXT, lane); have = true; } else have = false; }); \
        u = un_; } while (0)
    while (u < NALL) { C_STEP(PA, PB); if (u >= NALL) break; C_STEP(PB, PA); }
#undef C_STEP
    __syncthreads();
}
__device__ __forceinline__ void interval2(const Ctx& c, unsigned* ctr) {
    constexpr int PER = 4 * CB + 8 * CB, NAB = 8 * PER, NF = TC / 256;
    RUN_QUEUE(NAB + NF, {
        if (u >= NF) { const int ua = u - NF, grp = ua / PER, r = ua % PER, qb = 7 - grp;
            if (r < 8 * CB) { unitA(c, r >> 3, r & 7, qb); }
            else { const int r2 = r - 8 * CB, jj = 4 * qb + 3 - r2 / CB; unitB2(c, r2 % CB, jj); } }
        else unitCfix(c, u); });
}
#undef RUN_QUEUE
}


__device__ __forceinline__ Ctx fresh(const Ctx& c0) {
    Ctx c = c0;
    int wv = c0.wave; asm volatile("" : "+s"(wv)); const int tid = wv * 64 + lane_now();
    unsigned long long ws = (unsigned long long)c0.ws, out = (unsigned long long)c0.out, lds = (unsigned long long)(unsigned)(uintptr_t)c0.lds;
    asm volatile("" : "+s"(ws)); asm volatile("" : "+s"(out));
    int G = c0.G, bid = c0.bid, layer = c0.layer, row0 = c0.row0;
    asm volatile("" : "+s"(G)); asm volatile("" : "+s"(bid)); asm volatile("" : "+s"(layer)); asm volatile("" : "+s"(row0));
    c.tid = tid; c.lane = tid & 63; c.wave = wv;
    c.ws = (unsigned char*)(GAS unsigned char*)ws; c.out = (float*)(GAS float*)out; c.G = G; c.bid = bid; c.layer = layer; c.row0 = row0;
    c.gw = bid * NWAVES + c.wave; c.NGW = G * NWAVES;
    (void)lds;
    return c;
}

constexpr int STEPS_PER = 8, N_STEPS = 1 + 2 * NCH * STEPS_PER + 1;
template <int PH>
__global__ void __launch_bounds__(NT, 2) mk(Args args) {
    extern __shared__ __attribute__((aligned(16))) unsigned char lds_raw[];
    Ctx c;
    c.lds = (LAS unsigned char*)lds_raw;
    c.tid = threadIdx.x; c.lane = c.tid & 63; c.wave = __builtin_amdgcn_readfirstlane(c.tid >> 6);
    c.G = gridDim.x; c.bid = blockIdx.x; c.gw = c.bid * NWAVES + c.wave; c.NGW = c.G * NWAVES;
    c.ws = args.ws; c.out = args.out; c.in = args.in; c.dry = 0;
    volatile LAS unsigned* MISC = (volatile LAS unsigned*)(c.lds + MISC_OFF);
    if (c.tid < 32) MISC[c.tid] = 0u;
    __syncthreads();
    const int lo = PH < 0 ? args.lo : 0, hi = PH < 0 ? args.hi : 0;
    XcdBarrier bar; bar.bar = (unsigned*)(c.ws + WS_CTL) + CW_BAR; bar.x = 0; bar.st = nullptr;
    if constexpr (PH < 0) bar = xcd_barrier_post((unsigned*)(c.ws + WS_CTL) + CW_BAR, MISC + 8);
#define IN(k) (lo <= (k) && (k) < hi)
#define SEAM(k) do { if constexpr (PH < 0) { if (IN(k) && IN((k) + 1)) xcd_barrier(bar, c.wave); } } while (0)
#define ON(t, k) ((PH < 0 && IN(k)) || PH == (t))
    ctx_set(c, 0, 0);
    if constexpr (PH < 0 || PH == 0) if (ON(0, 0)) { { Ctx f = fresh(c); p0_prologue(f); } if constexpr (PH < 0) { xcd_barrier(bar, c.wave); Ctx f = fresh(c); p0_prologue_b(f); } SEAM(0); }
    const int lc0 = PH < 0 ? 0 : args.lo, lc1 = PH < 0 ? 2 * NCH : args.lo + 1;
    for (int lc = lc0; lc < lc1; ++lc) {
        const int base = 1 + lc * STEPS_PER;
        if (PH < 0 && (hi <= base || lo >= base + STEPS_PER)) continue;
        ctx_set(c, lc / NCH, lc % NCH);
        if constexpr (PH < 0 || PH == 1) if (ON(1, base + 0)) {
            { Ctx f = fresh(c);
              SubSched Sd{(const char*)(f.ws + WS_XQ + (size_t)f.row0 * 1024), (const char*)(f.ws + WS_W1Q + (size_t)f.layer * N1 * 1024), 512, 512, 8, TC / 256, N1 / 256 - 2, f.G, f.bid, 18, 2};
              EpiP1<true> E{f.ws, f.row0, f.layer, f.lds};
              { const u32x4* src = (const u32x4*)((const unsigned short*)((const unsigned*)(f.ws + WS_CTL) + CW_CS16) + (size_t)f.layer * N1);
                for (int i = f.tid; i < N1 / 8; i += NT) *(LAS u32x4*)(f.lds + L_CS16 + i * 16) = src[i];
                __syncthreads(); }
              pg8::gemm_phase<EpiP1<true>, SubSched, true, true>(f.lds, Sd, E, f.tid); }
            { Ctx f = fresh(c);
              SubSched Sd{(const char*)(B_XB(f) + (size_t)f.row0 * D), (const char*)B_W1T(f), 1024, 1024, 16, TC / 256, 2, f.G, f.bid, 0, 18};
              EpiP1<false> E{f.ws, f.row0, f.layer, f.lds};
              pg8::gemm_phase<EpiP1<false>, SubSched>(f.lds, Sd, E, f.tid); }
            SEAM(base + 0); }
        if constexpr (PH < 0 || PH == 2) if (ON(2, base + 1)) { { Ctx f = fresh(c); att::interval1(f, (unsigned*)(f.ws + WS_CTL) + CW_Q + (lc * 4 + 0) * 64, lc); } SEAM(base + 1); }
        if constexpr (PH < 0 || PH == 4) if (ON(4, base + 3)) { { Ctx f = fresh(c); att::interval2(f, (unsigned*)(f.ws + WS_CTL) + CW_Q + (lc * 4 + 1) * 64); } SEAM(base + 3); }
        if constexpr (PH < 0 || PH == 6) if (ON(6, base + 5)) {
            { Ctx f = fresh(c); MrgSched Sd{f.ws, f.layer, TC / 256, 4, f.G, f.bid}; EpiMrg E{f.ws};
              pg8::gemm_phase<EpiMrg, MrgSched>(f.lds, Sd, E, f.tid); }
            SEAM(base + 5); }
        if constexpr (PH < 0 || PH == 7) if (ON(7, base + 6)) {
            { Ctx f = fresh(c); UniSched Sd{(const char*)B_MRG(f), (const char*)B_WOT(f), 1024, 1024, 16, TC / 256, 4, f.G, f.bid};
              EpiOut E{f.ws, f.row0, f.layer};
              pg8::gemm_phase<EpiOut, UniSched>(f.lds, Sd, E, f.tid); }
            if (lc == 2 * NCH - 1) SEAM(base + 6); }
    }
    if constexpr (PH < 0 || PH == 9) if (ON(9, N_STEPS - 1)) { Ctx f = fresh(c); final_norm_rows(f, MALL - TC, MALL, f.gw, f.NGW); }
#undef IN
#undef SEAM
#undef ON
}

template <int PH> static void launch_ph(int grid, Args a, hipStream_t stream) {
    static bool attr = false;
    if (!attr) { (void)hipFuncSetAttribute((const void*)mk<PH>, hipFuncAttributeMaxDynamicSharedMemorySize, LDS_BYTES); attr = true; }
    hipLaunchKernelGGL(mk<PH>, dim3(grid), dim3(NT), LDS_BYTES, stream, a);
}
extern "C" void kernel_launch(void* const* d_in, const int* in_sizes, int n_in, void* d_out, int out_size, void* d_ws, size_t ws_size, hipStream_t stream) {
    static int grid = 0;
    if (grid == 0) {
        if (n_in != 14 || out_size != MALL * D || ws_size < WS_END) { fprintf(stderr, "kernel_launch: unexpected shapes (n_in %d out %d ws %zu need %zu)\n", n_in, out_size, ws_size, (size_t)WS_END); grid = -1; return; }
        int dev = 0, cus = 0;
        if (hipGetDevice(&dev) != hipSuccess || hipDeviceGetAttribute(&cus, hipDeviceAttributeMultiprocessorCount, dev) != hipSuccess) { grid = -1; return; }
        (void)hipGetLastError();
        int nb = 0;
        (void)hipFuncSetAttribute((const void*)mk<-1>, hipFuncAttributeMaxDynamicSharedMemorySize, LDS_BYTES);
        if (hipOccupancyMaxActiveBlocksPerMultiprocessor(&nb, (const void*)mk<-1>, NT, (size_t)LDS_BYTES) != hipSuccess || nb < 1) { (void)hipGetLastError(); fprintf(stderr, "kernel_launch: occupancy query says %d blocks per CU\n", nb); grid = -1; return; }
        grid = cus;
    }
    if (grid < 0) return;
    (void)hipMemsetAsync((char*)d_ws + WS_CTL, 0, CTL_ZERO_BYTES, stream);
    Args a{};
    for (int i = 0; i < 14; ++i) a.in[i] = (const float*)d_in[i];
    a.out = (float*)d_out; a.ws = (unsigned char*)d_ws;
    a.lo = 0; a.hi = N_STEPS;
    launch_ph<-1>(grid, a, stream);
}
```
